# Optimizing an MI355X kernel written in HIP

```python
import math
import jax
import jax.numpy as jnp
from jax import lax
import numpy as np

D_MODEL = 1024
BATCH = 4
SEQ = 4096
DEPTH = 1

N_META = 16
SSM_WIDTH = D_MODEL // 2
SSM_GROUP = 16
SSM_GROUPS = SSM_WIDTH // SSM_GROUP
SSM_STATE = 64
HEAD_DIM = 64
N_HEADS = D_MODEL // HEAD_DIM
N_KV_HEADS = 2
KV_REP = N_HEADS // N_KV_HEADS
WINDOW = 128
ATTN_BLOCK = 128
Q_WIDTH = N_HEADS * HEAD_DIM
KV_WIDTH = N_KV_HEADS * HEAD_DIM
IN_WIDTH = SSM_WIDTH + Q_WIDTH + 2 * KV_WIDTH + 2 * D_MODEL
N_EXPERTS = 32
TOP_K = 4
D_FF = D_MODEL
SWIGLU_ALPHA = 1.702
SWIGLU_LIMIT = 7.0
MOE_BLOCK = 128
RMS_EPS = 1e-5
NEG_INF = -1e30

kernel_name = "hybrid_s5_swa_sink_moe_meta"


def rms_norm(x, g):
    xf = x.astype(jnp.float32)
    y = xf * lax.rsqrt(jnp.mean(xf * xf, axis=-1, keepdims=True) + RMS_EPS)
    return (y * g.astype(jnp.float32)).astype(x.dtype)


def s5_mixer(u, a_re, a_im, log_dt, b_re, b_im, c_re, c_im, d_skip):
    bsz, seq_len, _ = u.shape
    f32 = jnp.float32
    uf = u.astype(f32)
    ug = uf.reshape(bsz, seq_len, SSM_GROUPS, SSM_GROUP)
    a_re, a_im = a_re.astype(f32), a_im.astype(f32)
    b_re, b_im = b_re.astype(f32), b_im.astype(f32)
    c_re, c_im = c_re.astype(f32), c_im.astype(f32)
    dt = jnp.exp(log_dt.astype(f32))[:, None]
    mag = jnp.exp(a_re * dt)
    ang = a_im * dt
    abar_re, abar_im = mag * jnp.cos(ang), mag * jnp.sin(ang)
    den = a_re * a_re + a_im * a_im
    nr, ni = abar_re - 1.0, abar_im
    coef_re = ((nr * a_re + ni * a_im) / den)[..., None]
    coef_im = ((ni * a_re - nr * a_im) / den)[..., None]
    bbar_re = coef_re * b_re - coef_im * b_im
    bbar_im = coef_re * b_im + coef_im * b_re
    bu_re = jnp.einsum('blgc,gpc->blgp', ug, bbar_re)
    bu_im = jnp.einsum('blgc,gpc->blgp', ug, bbar_im)
    ar = jnp.broadcast_to(abar_re[None, None], (1, seq_len, SSM_GROUPS, SSM_STATE))
    ai = jnp.broadcast_to(abar_im[None, None], (1, seq_len, SSM_GROUPS, SSM_STATE))

    def combine(e1, e2):
        a1r, a1i, b1r, b1i = e1
        a2r, a2i, b2r, b2i = e2
        return (a2r * a1r - a2i * a1i,
                a2r * a1i + a2i * a1r,
                a2r * b1r - a2i * b1i + b2r,
                a2r * b1i + a2i * b1r + b2i)

    _, _, s_re, s_im = lax.associative_scan(combine, (ar, ai, bu_re, bu_im), axis=1)
    y = jnp.einsum('blgp,gcp->blgc', s_re, c_re) - jnp.einsum('blgp,gcp->blgc', s_im, c_im)
    y = y.reshape(bsz, seq_len, SSM_WIDTH) + d_skip.astype(f32) * uf
    return y.astype(u.dtype)


def window_attention(q, k, v, sinks):
    bsz, seq_len = q.shape[:2]
    s_real = seq_len - N_META
    nb = s_real // ATTN_BLOCK
    scale = HEAD_DIM ** -0.5
    f32 = jnp.float32
    q = q.reshape(bsz, seq_len, N_KV_HEADS, KV_REP, HEAD_DIM)
    qm, qr = q[:, :N_META], q[:, N_META:]
    km, kr = k[:, :N_META], k[:, N_META:]
    vm, vr = v[:, :N_META], v[:, N_META:]
    sink = sinks.astype(f32).reshape(N_KV_HEADS, KV_REP)

    s_mm = jnp.einsum('bqkrd,bmkd->bkrqm', qm, km).astype(f32) * scale
    causal = jnp.arange(N_META)[:, None] >= jnp.arange(N_META)[None, :]
    s_mm = jnp.where(causal, s_mm, NEG_INF)
    sink_m = jnp.broadcast_to(sink[None, :, :, None, None], (bsz, N_KV_HEADS, KV_REP, N_META, 1))
    p_mm = jax.nn.softmax(jnp.concatenate([s_mm, sink_m], axis=-1), axis=-1)[..., :N_META]
    out_m = jnp.einsum('bkrqm,bmkd->bqkrd', p_mm.astype(v.dtype), vm)

    qb = qr.reshape(bsz, nb, ATTN_BLOCK, N_KV_HEADS, KV_REP, HEAD_DIM)

    def band(t):
        tp = jnp.pad(t, ((0, 0), (ATTN_BLOCK, 0), (0, 0), (0, 0)))
        tp = tp.reshape(bsz, nb + 1, ATTN_BLOCK, N_KV_HEADS, HEAD_DIM)
        return jnp.concatenate([tp[:, :-1], tp[:, 1:]], axis=2)

    kb, vb = band(kr), band(vr)
    s_band = jnp.einsum('bnqkrd,bnskd->bnkrqs', qb, kb).astype(f32) * scale
    qpos = jnp.arange(nb)[:, None, None] * ATTN_BLOCK + jnp.arange(ATTN_BLOCK)[None, :, None]
    kpos = (jnp.arange(nb)[:, None, None] - 1) * ATTN_BLOCK + jnp.arange(2 * ATTN_BLOCK)[None, None, :]
    rel = qpos - kpos
    vis = (rel >= 0) & (rel < WINDOW) & (kpos >= 0)
    s_band = jnp.where(vis[None, :, None, None], s_band, NEG_INF)
    s_meta = jnp.einsum('bnqkrd,bmkd->bnkrqm', qb, km).astype(f32) * scale
    sink_r = jnp.broadcast_to(sink[None, None, :, :, None, None],
                              (bsz, nb, N_KV_HEADS, KV_REP, ATTN_BLOCK, 1))
    p = jax.nn.softmax(jnp.concatenate([s_meta, s_band, sink_r], axis=-1), axis=-1).astype(v.dtype)
    out_r = (jnp.einsum('bnkrqm,bmkd->bnqkrd', p[..., :N_META], vm)
             + jnp.einsum('bnkrqs,bnskd->bnqkrd', p[..., N_META:N_META + 2 * ATTN_BLOCK], vb))
    out_r = out_r.reshape(bsz, s_real, N_KV_HEADS, KV_REP, HEAD_DIM)
    out = jnp.concatenate([out_m, out_r], axis=1)
    return out.reshape(bsz, seq_len, Q_WIDTH)


def clamped_swiglu(x_glu, x_lin):
    x_glu = jnp.minimum(x_glu, SWIGLU_LIMIT)
    x_lin = jnp.clip(x_lin, -SWIGLU_LIMIT, SWIGLU_LIMIT)
    return x_glu * jax.nn.sigmoid(SWIGLU_ALPHA * x_glu) * (x_lin + 1.0)


def moe_ffn(h, router_w, router_b, w_up, b_up, w_down, b_down):
    n_tok = h.shape[0]
    n_assign = n_tok * TOP_K
    logits = (h @ router_w + router_b).astype(jnp.float32)
    top_vals, top_idx = lax.top_k(logits, TOP_K)
    gates = jax.nn.softmax(top_vals, axis=-1)
    e_flat = top_idx.reshape(-1)
    tok_flat = jnp.repeat(jnp.arange(n_tok, dtype=jnp.int32), TOP_K)
    g_flat = gates.reshape(-1)
    order = jnp.argsort(e_flat)
    e_s, tok_s, g_s = e_flat[order], tok_flat[order], g_flat[order]
    counts = jnp.bincount(e_flat, length=N_EXPERTS)
    padded = ((counts + MOE_BLOCK - 1) // MOE_BLOCK) * MOE_BLOCK
    start = jnp.cumsum(counts) - counts
    block_end = jnp.cumsum(padded)
    pstart = block_end - padded
    dest = pstart[e_s] + (jnp.arange(n_assign) - start[e_s])
    n_blocks = (n_assign + N_EXPERTS * (MOE_BLOCK - 1) + MOE_BLOCK - 1) // MOE_BLOCK
    n_rows = n_blocks * MOE_BLOCK
    row_tok = jnp.zeros((n_rows,), jnp.int32).at[dest].set(tok_s)
    row_g = jnp.zeros((n_rows,), jnp.float32).at[dest].set(g_s)
    block_expert = jnp.minimum(
        jnp.searchsorted(block_end, jnp.arange(n_blocks) * MOE_BLOCK, side='right'), N_EXPERTS - 1)

    def expert_block(args):
        tok, e = args
        xb = h[tok]
        up = xb @ w_up[e] + b_up[e]
        act = clamped_swiglu(up[:, :D_FF], up[:, D_FF:])
        return act @ w_down[e] + b_down[e]

    y = lax.map(expert_block, (row_tok.reshape(n_blocks, MOE_BLOCK), block_expert))
    y = y.reshape(n_rows, -1) * row_g[:, None].astype(h.dtype)
    return jax.ops.segment_sum(y, row_tok, num_segments=n_tok)


def setup_inputs(seed: int = 0) -> dict:
    key = jax.random.key(seed)
    ks = jax.random.split(key, 24)
    f32 = jnp.float32
    nrm = lambda k, shape, s: jax.random.normal(k, shape, f32) * s
    x = jax.random.normal(ks[0], (BATCH, SEQ, D_MODEL), f32)
    meta_tokens = nrm(ks[1], (N_META, D_MODEL), 1.0)
    mix_norm_g = 1.0 + nrm(ks[2], (DEPTH, D_MODEL), 0.05)
    w_in = nrm(ks[3], (DEPTH, D_MODEL, IN_WIDTH), D_MODEL ** -0.5)
    ssm_a_re = -0.5 * jnp.exp(nrm(ks[4], (DEPTH, SSM_GROUPS, SSM_STATE), 0.02))
    ssm_a_im = jnp.broadcast_to(math.pi * jnp.arange(SSM_STATE, dtype=f32),
                                (DEPTH, SSM_GROUPS, SSM_STATE))
    ssm_log_dt = jax.random.uniform(ks[5], (DEPTH, SSM_GROUPS), f32,
                                    math.log(0.001), math.log(0.1))
    ssm_b_re = nrm(ks[6], (DEPTH, SSM_GROUPS, SSM_STATE, SSM_GROUP), (2 * SSM_GROUP) ** -0.5)
    ssm_b_im = nrm(ks[7], (DEPTH, SSM_GROUPS, SSM_STATE, SSM_GROUP), (2 * SSM_GROUP) ** -0.5)
    ssm_c_re = nrm(ks[8], (DEPTH, SSM_GROUPS, SSM_GROUP, SSM_STATE), (2 * SSM_STATE) ** -0.5)
    ssm_c_im = nrm(ks[9], (DEPTH, SSM_GROUPS, SSM_GROUP, SSM_STATE), (2 * SSM_STATE) ** -0.5)
    ssm_d = nrm(ks[10], (DEPTH, SSM_WIDTH), 1.0)
    w_ssm_glu = nrm(ks[11], (DEPTH, SSM_WIDTH, 2 * D_MODEL), SSM_WIDTH ** -0.5)
    attn_sinks = nrm(ks[12], (DEPTH, N_HEADS), 0.5)
    w_attn_o = nrm(ks[13], (DEPTH, Q_WIDTH, D_MODEL), Q_WIDTH ** -0.5)
    w_out = nrm(ks[14], (DEPTH, D_MODEL, D_MODEL), D_MODEL ** -0.5)
    ffn_norm_g = 1.0 + nrm(ks[15], (DEPTH, D_MODEL), 0.05)
    router_w = nrm(ks[16], (DEPTH, D_MODEL, N_EXPERTS), D_MODEL ** -0.5)
    router_b = nrm(ks[17], (DEPTH, N_EXPERTS), 0.01)
    w_up = nrm(ks[18], (DEPTH, N_EXPERTS, D_MODEL, 2 * D_FF), D_MODEL ** -0.5)
    b_up = nrm(ks[19], (DEPTH, N_EXPERTS, 2 * D_FF), 0.01)
    w_down = nrm(ks[20], (DEPTH, N_EXPERTS, D_FF, D_MODEL), D_FF ** -0.5)
    b_down = nrm(ks[21], (DEPTH, N_EXPERTS, D_MODEL), 0.01)
    final_norm_g = 1.0 + nrm(ks[22], (D_MODEL,), 0.05)
    return {"x": x, "meta_tokens": meta_tokens, "mix_norm_g": mix_norm_g, "w_in": w_in,
            "ssm_a_re": ssm_a_re, "ssm_a_im": ssm_a_im, "ssm_log_dt": ssm_log_dt,
            "ssm_b_re": ssm_b_re, "ssm_b_im": ssm_b_im, "ssm_c_re": ssm_c_re, "ssm_c_im": ssm_c_im,
            "ssm_d": ssm_d, "w_ssm_glu": w_ssm_glu, "attn_sinks": attn_sinks, "w_attn_o": w_attn_o,
            "w_out": w_out, "ffn_norm_g": ffn_norm_g, "router_w": router_w, "router_b": router_b,
            "w_up": w_up, "b_up": b_up, "w_down": w_down, "b_down": b_down,
            "final_norm_g": final_norm_g}


def reference(x, meta_tokens, mix_norm_g, w_in, ssm_a_re, ssm_a_im, ssm_log_dt, ssm_b_re, ssm_b_im,
              ssm_c_re, ssm_c_im, ssm_d, w_ssm_glu, attn_sinks, w_attn_o, w_out, ffn_norm_g,
              router_w, router_b, w_up, b_up, w_down, b_down, final_norm_g):
    bsz = x.shape[0]
    meta = jnp.broadcast_to(meta_tokens[None].astype(x.dtype), (bsz, N_META, D_MODEL))
    h = jnp.concatenate([meta, x], axis=1)
    seq_len = h.shape[1]
    splits = [SSM_WIDTH, SSM_WIDTH + Q_WIDTH, SSM_WIDTH + Q_WIDTH + KV_WIDTH,
              SSM_WIDTH + Q_WIDTH + 2 * KV_WIDTH, SSM_WIDTH + Q_WIDTH + 2 * KV_WIDTH + D_MODEL]
    for layer in range(DEPTH):
        hn = rms_norm(h, mix_norm_g[layer])
        proj = hn @ w_in[layer]
        u, q, k, v, g_ssm, g_attn = jnp.split(proj, splits, axis=-1)
        y_ssm = s5_mixer(u, ssm_a_re[layer], ssm_a_im[layer], ssm_log_dt[layer], ssm_b_re[layer],
                         ssm_b_im[layer], ssm_c_re[layer], ssm_c_im[layer], ssm_d[layer])
        glu = jax.nn.gelu(y_ssm) @ w_ssm_glu[layer]
        branch_ssm = glu[..., :D_MODEL] * jax.nn.sigmoid(glu[..., D_MODEL:])
        attn = window_attention(q.reshape(bsz, seq_len, N_HEADS, HEAD_DIM),
                                k.reshape(bsz, seq_len, N_KV_HEADS, HEAD_DIM),
                                v.reshape(bsz, seq_len, N_KV_HEADS, HEAD_DIM),
                                attn_sinks[layer])
        branch_attn = attn @ w_attn_o[layer]
        merged = jax.nn.sigmoid(g_ssm) * branch_ssm + jax.nn.sigmoid(g_attn) * branch_attn
        h = h + merged @ w_out[layer]
        hf = rms_norm(h, ffn_norm_g[layer]).reshape(bsz * seq_len, D_MODEL)
        h = h + moe_ffn(hf, router_w[layer], router_b[layer], w_up[layer], b_up[layer],
                        w_down[layer], b_down[layer]).reshape(bsz, seq_len, D_MODEL)
    h = rms_norm(h, final_norm_g)
    return h[:, N_META:]
```

```cpp
#include <hip/hip_runtime.h>
#include <cstdio>
#include <cstdint>
#include <type_traits>

typedef unsigned short bf16_t;
typedef float f32x4 __attribute__((ext_vector_type(4)));
typedef unsigned u32x4 __attribute__((ext_vector_type(4)));
typedef unsigned u32x2 __attribute__((ext_vector_type(2)));

constexpr int D = 1024, BATCH = 4, SEQ = 4096, NMETA = 16;
constexpr int NTOK = BATCH * SEQ;
constexpr int MROWS = NTOK + 256;
constexpr int SSM_W = 512, SSM_GC = 16, NGRP = 32, NSTATE = 64, YG_P = 1024;
constexpr int HD = 64, NH = 16, NKVH = 2, KVREP = 8, WIN = 128;
constexpr int INW = 3840;
constexpr int COL_U = 0, COL_Q = 512, COL_K = 1536, COL_V = 1664, COL_GS = 1792, COL_GA = 2816;
constexpr int NEXP = 32, TOPK = 4, DFF = 1024;
constexpr int MAXSLOT = 73728;
constexpr float RMS_EPS = 1e-5f;
constexpr float LOG2E = 1.4426950408889634f;
constexpr float QSCALE = 0.125f * LOG2E;

constexpr size_t al256(size_t x) { return (x + 255) & ~(size_t)255; }
constexpr size_t WS_CTL = 0;
constexpr size_t CTL_BYTES = 1u << 16;
constexpr size_t WS_WT_IN = WS_CTL + CTL_BYTES;
constexpr size_t WS_WT_GLU = WS_WT_IN + al256((size_t)INW * D * 2);
constexpr size_t WS_WT_O = WS_WT_GLU + al256((size_t)2048 * 1024 * 2);
constexpr size_t WS_WT_OUT = WS_WT_O + al256((size_t)D * D * 2);
constexpr size_t WS_WT_UP = WS_WT_OUT + al256((size_t)D * D * 2);
constexpr size_t WS_WT_DN = WS_WT_UP + al256((size_t)NEXP * 2048 * D * 2);
constexpr size_t WS_WR = WS_WT_DN + al256((size_t)NEXP * D * DFF * 2);
constexpr size_t WS_ABAR = WS_WR + al256((size_t)D * NEXP * 4);
constexpr size_t WS_BBAR = WS_ABAR + al256((size_t)NGRP * NSTATE * 2 * 4);
constexpr size_t WS_XB = WS_BBAR + al256((size_t)NGRP * NSTATE * 16 * 2 * 4);
constexpr size_t WS_RS1 = WS_XB + al256((size_t)MROWS * D * 2);
constexpr size_t WS_U = WS_RS1 + al256((size_t)MROWS * 4);
constexpr size_t WS_Q = WS_U + al256((size_t)MROWS * SSM_W * 2);
constexpr size_t WS_KV = WS_Q + al256((size_t)MROWS * D * 2);
constexpr size_t WS_GS = WS_KV + al256((size_t)MROWS * 256 * 2);
constexpr size_t WS_GA = WS_GS + al256((size_t)MROWS * D * 2);
constexpr size_t WS_ATT = WS_GA + al256((size_t)MROWS * D * 2);
constexpr size_t WS_YG = WS_ATT + al256((size_t)NTOK * D * 2);
constexpr size_t WS_T1 = WS_YG + al256((size_t)NTOK * D * 2);
constexpr size_t WS_MG = WS_T1 + al256((size_t)NTOK * D * 2);
constexpr size_t WS_H1 = WS_MG + al256((size_t)NTOK * D * 2);
constexpr size_t WS_H1B = WS_H1 + al256((size_t)NTOK * D * 4);
constexpr size_t WS_RS2 = WS_H1B + al256((size_t)NTOK * D * 2);
constexpr size_t WS_LTOK = WS_RS2 + al256((size_t)NTOK * 4);
constexpr size_t WS_LGATE = WS_LTOK + al256((size_t)NEXP * NTOK * 4);
constexpr size_t WS_TSLOT = WS_LGATE + al256((size_t)NEXP * NTOK * 4);
constexpr size_t WS_ACT = WS_TSLOT + al256((size_t)NTOK * 4 * 4);
constexpr size_t WS_YS = WS_ACT + al256((size_t)MAXSLOT * DFF * 2);
constexpr size_t WS_BB = WS_YS + al256((size_t)MAXSLOT * D * 2);
constexpr size_t WS_CC = WS_BB + al256((size_t)NGRP * 128 * 16 * 2);
constexpr size_t WS_E = WS_CC + al256((size_t)NGRP * 16 * 128 * 2);
constexpr size_t WS_LRS = WS_E + al256((size_t)BATCH * NGRP * 16 * 128 * 4);
constexpr size_t WS_WRH = WS_LRS + al256((size_t)NEXP * NTOK * 4);
constexpr size_t WS_WRL = WS_WRH + al256((size_t)NEXP * D * 2);
constexpr size_t WS_END = WS_WRL + al256((size_t)NEXP * D * 2);
constexpr int CW_GCOUNT = 64;

struct P {
    const float *x, *meta, *mix_g, *w_in, *a_re, *a_im, *log_dt, *b_re, *b_im, *c_re, *c_im, *dskip, *w_glu, *sinks, *w_o, *w_out,
        *ffn_g, *router_w, *router_b, *w_up, *b_up, *w_down, *b_down, *final_g;
    float* out;
    unsigned char* ws;
};

#define DI __device__ __forceinline__
DI float bf2f(bf16_t h) { return __uint_as_float(((unsigned)h) << 16); }
DI bf16_t f2bf(float f) { unsigned u = __float_as_uint(f); return (bf16_t)((u + 0x7fffu + ((u >> 16) & 1u)) >> 16); }
typedef float f32x2_t __attribute__((ext_vector_type(2)));
typedef __bf16 bf16x2_t __attribute__((ext_vector_type(2)));
DI unsigned pk2(float lo, float hi) { const f32x2_t v = {lo, hi}; return __builtin_bit_cast(unsigned, __builtin_convertvector(v, bf16x2_t)); }
DI float sigmoidf_(float x) { return __builtin_amdgcn_rcpf(1.0f + __builtin_amdgcn_exp2f(-LOG2E * x)); }
DI float sigmoid_pre(float t) { return __builtin_amdgcn_rcpf(1.0f + __builtin_amdgcn_exp2f(t)); }
DI float gelu_tanh(float x) { const float u2 = 1.5957691216057308f * (x + 0.044715f * x * x * x); return x * __builtin_amdgcn_rcpf(1.0f + __builtin_amdgcn_exp2f(-LOG2E * u2)); }
DI float wave_sum(float v) {
#pragma unroll
    for (int o = 1; o < 64; o <<= 1) v += __shfl_xor(v, o);
    return v;
}
DI int pair_row(int n, int half) { const int j = n < half ? n : n - half; return (j >> 7) * 256 + (n < half ? 0 : 128) + (j & 127); }

DI void store4_bf16(bf16_t* dst, const float* v) { u32x2 o; o.x = pk2(v[0], v[1]); o.y = pk2(v[2], v[3]); *(u32x2*)dst = o; }
DI void load4_bf16(const bf16_t* src, float* v) { const u32x2 o = *(const u32x2*)src; v[0] = __uint_as_float(o.x << 16); v[1] = __uint_as_float(o.x & 0xffff0000u); v[2] = __uint_as_float(o.y << 16); v[3] = __uint_as_float(o.y & 0xffff0000u); }


#define LAS __attribute__((address_space(3)))
typedef short bf16x8 __attribute__((ext_vector_type(8)));
namespace pg8 {
constexpr int BM = 256, BK = 64, HALF = 128, HTB = HALF * BK * 2, STAGE_BYTES = 8 * HTB, NXCD = 8, WGM = 8;
DI int lds_byte(int r, int c) { const int st = (r >> 4) * 2 + (c >> 5), rr = r & 15, cc = c & 31, ob = rr * 64 + cc * 2; return st * 1024 + (ob ^ (((ob >> 9) & 1) << 5)); }
DI void stage_rc(int b, int& R, int& C) { const int st = b / 1024, sb = b % 1024, swz = sb ^ (((sb >> 9) & 1) << 5); R = (st >> 1) * 16 + swz / 64; C = (st & 1) * 32 + (swz % 64) / 2; }
DI int perm32(int rho) { const int n = rho >> 4, i = rho & 15; return 8 * (i >> 2) + 4 * n + (i & 3); }
DI void static_order(int L, int nM, int nN, int& pm, int& pn) {
    const int nwg = nM * nN; int wgid = L;
    { const int q = nwg / NXCD, r = nwg % NXCD, xcd = wgid % NXCD, off = wgid / NXCD; wgid = (xcd < r ? xcd * (q + 1) : r * (q + 1) + (xcd - r) * q) + off; }
    const int nig = WGM * nN, gid = wgid / nig, fm = gid * WGM, gsz = (nM - fm) < WGM ? (nM - fm) : WGM;
    pm = fm + ((wgid % nig) % gsz); pn = (wgid % nig) / gsz;
}
struct GU { int kind, pm, pn, e, pos0, cnt, hm; };
}

typedef int v8i_t __attribute__((ext_vector_type(8)));
DI void mfma_mx8(f32x4& d, v8i_t a, v8i_t b, int sa, int sb) { asm volatile("v_mfma_scale_f32_16x16x128_f8f6f4 %0, %1, %2, %0, %3, %4 op_sel_hi:[0,0,0]" : "+v"(d) : "v"(a), "v"(b), "v"(sa), "v"(sb)); }
DI unsigned pk4_fp8(float a, float b, float c, float d) { int w = 0; w = __builtin_amdgcn_cvt_pk_fp8_f32(a, b, w, false); w = __builtin_amdgcn_cvt_pk_fp8_f32(c, d, w, true); return (unsigned)w; }
DI void store8_fp8(unsigned char* dst, const float* v) { u32x2 o; o.x = pk4_fp8(v[0], v[1], v[2], v[3]); o.y = pk4_fp8(v[4], v[5], v[6], v[7]); *(u32x2*)dst = o; }
constexpr float YS_SCALE = 16.0f;
constexpr float W8_SCALE = 64.0f;
constexpr int MX_SCALE_B = 0x7c7c7c7c;
DI void store8_bf16(bf16_t* dst, const float* v) { u32x4 o; o.x = pk2(v[0], v[1]); o.y = pk2(v[2], v[3]); o.z = pk2(v[4], v[5]); o.w = pk2(v[6], v[7]); *(u32x4*)dst = o; }
DI void unpack8_bf16(const u32x4 o, float* v) {
    v[0] = __uint_as_float(o.x << 16); v[1] = __uint_as_float(o.x & 0xffff0000u); v[2] = __uint_as_float(o.y << 16); v[3] = __uint_as_float(o.y & 0xffff0000u);
    v[4] = __uint_as_float(o.z << 16); v[5] = __uint_as_float(o.z & 0xffff0000u); v[6] = __uint_as_float(o.w << 16); v[7] = __uint_as_float(o.w & 0xffff0000u); }
DI void load8_bf16(const bf16_t* src, float* v) { const u32x4 o = *(const u32x4*)src;
    v[0] = __uint_as_float(o.x << 16); v[1] = __uint_as_float(o.x & 0xffff0000u); v[2] = __uint_as_float(o.y << 16); v[3] = __uint_as_float(o.y & 0xffff0000u);
    v[4] = __uint_as_float(o.z << 16); v[5] = __uint_as_float(o.z & 0xffff0000u); v[6] = __uint_as_float(o.w << 16); v[7] = __uint_as_float(o.w & 0xffff0000u); }
constexpr int LDS_COLMETA = 131072 + 6144 + 256;
constexpr int LDS_MOETAB = 131072 + 6144;
DI int moe_table(LAS unsigned char* lds, const unsigned* gcount) {
    const int j = threadIdx.x & 31;
    const int cn = (int)__hip_atomic_load(gcount + j, __ATOMIC_RELAXED, __HIP_MEMORY_SCOPE_AGENT), nt = (cn + 255) >> 8;
    int incl = nt;
#pragma unroll
    for (int d = 1; d < 32; d <<= 1) { const int v = __shfl_up(incl, d, 32); if (j >= d) incl += v; }
    LAS int* tab = (LAS int*)(lds + LDS_MOETAB); tab[2 * j] = incl - nt; tab[2 * j + 1] = cn;
    return __builtin_amdgcn_readlane(incl, 31);
}
constexpr int LDS_ROWMETA = 131072;
template <int PHASE> struct GemmCtx {
    static constexpr int phase = PHASE;
    unsigned char* ws; const float* x; const float* b_up; const float* b_down; const float* fg;
    int G, c, T;
    const LAS int* tab;
    DI const unsigned* gcount() const { return (const unsigned*)(ws + WS_CTL) + CW_GCOUNT; }
    DI bool next(int i, pg8::GU& u) const {
        u.e = 0; u.pos0 = 0; u.cnt = 0; u.hm = -1;
        if (phase == 1) { const int L = i * G + c; if (L >= 65 * 15) return false; u.kind = 1; pg8::static_order(L, 65, 15, u.pm, u.pn); return true; }
        if (phase == 4) { const int su = (i / 3) * G + c, sub = i % 3; if (su >= 256) return false; int pm, pn2; pg8::static_order(su, 64, 4, pm, pn2);
            u.pm = pm; if (sub < 2) { u.kind = 2; u.pn = 2 * pn2 + sub; } else { u.kind = 3; u.pn = pn2; } return true; }
        if (phase == 5) { const int L = i * G + c; if (L >= 256) return false; u.kind = 4; pg8::static_order(L, 64, 4, u.pm, u.pn); return true; }
        const int nN = phase == 7 ? 8 : 4, U = T * nN, nfull = (U / G) * G, tail = U - nfull; const bool split = tail > 0 && 2 * tail <= G;
        int L = i * G + c;
        if (L >= nfull) { const int j = L - nfull; if (j >= (split ? 2 * tail : tail)) return false; L = nfull + (split ? (j >> 1) : j); u.hm = split ? (j & 1) : -1; }
        u.kind = phase == 7 ? 5 : 6; pg8::static_order(L, T, nN, u.pm, u.pn);
        const int j = threadIdx.x & 31; const int t0 = tab[2 * j], cn = tab[2 * j + 1];
        const unsigned long long hit = __ballot(u.pm >= t0 && u.pm < t0 + ((cn + 255) >> 8));
        const int e = hit ? (int)__builtin_ctzll(hit) : 0;
        u.e = e; u.pos0 = (u.pm - __builtin_amdgcn_readlane(t0, e)) * 256; u.cnt = __builtin_amdgcn_readlane(cn, e);
        if (u.hm < 0 && u.pos0 + 128 >= u.cnt) u.hm = 0;
        return true;
    }
    DI void operands(const pg8::GU& u, const char*& A, const char*& B, int& nt) const {
        nt = 16;
        switch (PHASE == 4 ? u.kind : (PHASE == 1 ? 1 : PHASE == 5 ? 4 : PHASE == 7 ? 5 : 6)) {
        case 1: A = (const char*)(ws + WS_XB); B = (const char*)(ws + WS_WT_IN); break;
        case 2: A = (const char*)(ws + WS_YG); B = (const char*)(ws + WS_WT_GLU); nt = 8; break;
        case 3: A = (const char*)(ws + WS_ATT); B = (const char*)(ws + WS_WT_O); break;
        case 4: A = (const char*)(ws + WS_MG); B = (const char*)(ws + WS_WT_OUT); break;
        case 5: A = (const char*)(ws + WS_H1B); B = (const char*)(ws + WS_WT_UP) + (size_t)u.e * 2048 * D; nt = 8; break;
        default: A = (const char*)(ws + WS_ACT); B = (const char*)(ws + WS_WT_DN) + (size_t)u.e * D * DFF; nt = 8; break;
        }
        constexpr size_t pitch = (PHASE == 7 || PHASE == 8) ? 1024 : 2048;
        B += (size_t)u.pn * 256 * pitch;
        if (PHASE != 7) A += (size_t)u.pm * 256 * pitch;
    }
    DI void rm_issue(const pg8::GU& u, int slot, LAS unsigned char* lds, int tid, int wid) const {
        if (PHASE != 1 && PHASE != 7 && PHASE != 8) return;
        LAS unsigned* rs = (LAS unsigned*)(lds + LDS_ROWMETA + slot * 1024 + (wid & 3) * 256);
        LAS unsigned* rt = (LAS unsigned*)(lds + LDS_ROWMETA + 3072 + slot * 1024 + (wid & 3) * 256);
        LAS unsigned* cm = (LAS unsigned*)(lds + LDS_COLMETA + slot * 1024 + (wid & 3) * 256);
        asm volatile("" : "+v"(tid));
        const unsigned lo = (unsigned)(tid & 255) * 4u;
        if (PHASE == 1) { const char* b = (const char*)(ws + WS_RS1) + (size_t)u.pm * 1024; asm volatile("" : "+s"(b));
            if (wid < 4) __builtin_amdgcn_global_load_lds((const unsigned*)(b + lo), rs, 4, 0, 0); }
        if (PHASE == 7) { const size_t so = ((size_t)u.e * NTOK + u.pos0) * 4; const char* b0 = (const char*)(ws + WS_LTOK) + so; const char* b1 = (const char*)(ws + WS_LRS) + so;
            const char* bb = (const char*)(b_up + (size_t)u.e * 2 * DFF + u.pn * 128); asm volatile("" : "+s"(b0), "+s"(b1), "+s"(bb));
            if (wid < 4) { __builtin_amdgcn_global_load_lds((const unsigned*)(b0 + lo), rt, 4, 0, 0); __builtin_amdgcn_global_load_lds((const unsigned*)(b1 + lo), rs, 4, 0, 0); }
            else { const int i = tid & 255; __builtin_amdgcn_global_load_lds((const unsigned*)(bb + (unsigned)((i >> 7) * DFF + (i & 127)) * 4u), cm, 4, 0, 0); } }
        if (PHASE == 8) { const char* b = (const char*)(ws + WS_LGATE) + ((size_t)u.e * NTOK + u.pos0) * 4; const char* bb = (const char*)(b_down + (size_t)u.e * D + u.pn * 256); asm volatile("" : "+s"(b), "+s"(bb));
            if (wid < 4) __builtin_amdgcn_global_load_lds((const unsigned*)(b + lo), rs, 4, 0, 0);
            else __builtin_amdgcn_global_load_lds((const unsigned*)(bb + lo), cm, 4, 0, 0); }
    }
    DI void acc_init(f32x4 (&acc)[2][2][4][2], const pg8::GU& u, int wr, int wc, int fr, int fq) const {
#pragma unroll
        for (int ai = 0; ai < 2; ++ai)
#pragma unroll
            for (int bj = 0; bj < 2; ++bj)
#pragma unroll
                for (int m = 0; m < 4; ++m)
#pragma unroll
                    for (int n = 0; n < 2; ++n) {
                        if (PHASE == 5) { const size_t row = (size_t)u.pm * 256 + ai * 128 + wr * 64 + m * 16 + fr;
                            const u32x2 q = *(const u32x2*)((const bf16_t*)(ws + WS_XB) + row * D + u.pn * 256 + bj * 128 + wc * 32 + 8 * fq + 4 * n);
                            acc[ai][bj][m][n] = (f32x4){__uint_as_float(q.x << 16), __uint_as_float(q.x & 0xffff0000u), __uint_as_float(q.y << 16), __uint_as_float(q.y & 0xffff0000u)}; }
                        else acc[ai][bj][m][n] = (f32x4){0.f, 0.f, 0.f, 0.f};
                    }
    }
    DI void epilogue(const f32x4 (&acc)[2][2][4][2], const pg8::GU& u, int wr, int wc, int fr, int fq, const LAS float* rs, const LAS float* cm) const {
        const int kind = PHASE == 4 ? u.kind : (PHASE == 1 ? 1 : PHASE == 5 ? 4 : PHASE == 7 ? 5 : 6);
        int cl8 = wc * 32 + 8 * fq; asm volatile("" : "+v"(cl8), "+v"(fr));
        float cb0[8], cb1[8];
        if (kind == 4) { const float* gg = fg + u.pn * 256 + cl8;
#pragma unroll
            for (int j = 0; j < 8; ++j) { cb0[j] = gg[j]; cb1[j] = gg[128 + j]; } }
        if (kind == 5 || kind == 6) {
#pragma unroll
            for (int j = 0; j < 8; ++j) { cb0[j] = cm[cl8 + j]; cb1[j] = cm[128 + cl8 + j] + (kind == 5 ? 1.0f : 0.0f); } }
        if (kind == 2) {
            u32x4 lg[2][4];
#pragma unroll
            for (int ai = 0; ai < 2; ++ai)
#pragma unroll
                for (int m = 0; m < 4; ++m) { const size_t row = (size_t)u.pm * 256 + ai * 128 + wr * 64 + m * 16 + fr;
                    lg[ai][m] = __builtin_nontemporal_load((const u32x4*)((const bf16_t*)(ws + WS_GS) + row * D + u.pn * 128 + cl8)); }
#pragma unroll
            for (int ai = 0; ai < 2; ++ai)
#pragma unroll
                for (int m = 0; m < 4; ++m) { const size_t row = (size_t)u.pm * 256 + ai * 128 + wr * 64 + m * 16 + fr;
                    const float a0[8] = {acc[ai][0][m][0].x, acc[ai][0][m][0].y, acc[ai][0][m][0].z, acc[ai][0][m][0].w, acc[ai][0][m][1].x, acc[ai][0][m][1].y, acc[ai][0][m][1].z, acc[ai][0][m][1].w};
                    const float a1[8] = {acc[ai][1][m][0].x, acc[ai][1][m][0].y, acc[ai][1][m][0].z, acc[ai][1][m][0].w, acc[ai][1][m][1].x, acc[ai][1][m][1].y, acc[ai][1][m][1].z, acc[ai][1][m][1].w};
                    float o[8], gs[8]; unpack8_bf16(lg[ai][m], gs);
#pragma unroll
                    for (int j = 0; j < 8; ++j) o[j] = gs[j] * a0[j] * sigmoidf_(a1[j]);
                    store8_bf16((bf16_t*)(ws + WS_T1) + row * D + u.pn * 128 + cl8, o); }
            return;
        }
        if (kind == 2 || kind == 3) {
#pragma unroll
            for (int ai = 0; ai < 2; ++ai) {
                u32x4 ld[4][4];
#pragma unroll
                for (int m = 0; m < 4; ++m) { const size_t row = (size_t)u.pm * 256 + ai * 128 + wr * 64 + m * 16 + fr;
                    if (kind == 2) ld[m][0] = __builtin_nontemporal_load((const u32x4*)((const bf16_t*)(ws + WS_GS) + row * D + u.pn * 128 + cl8));
                    else {
#pragma unroll
                        for (int bj = 0; bj < 2; ++bj) { const size_t off = row * D + u.pn * 256 + bj * 128 + cl8;
                            ld[m][2 * bj] = __builtin_nontemporal_load((const u32x4*)((const bf16_t*)(ws + WS_GA) + off)); ld[m][2 * bj + 1] = *(const u32x4*)((const bf16_t*)(ws + WS_T1) + off); } } }
#pragma unroll
                for (int m = 0; m < 4; ++m) { const size_t row = (size_t)u.pm * 256 + ai * 128 + wr * 64 + m * 16 + fr;
                    const float a0[8] = {acc[ai][0][m][0].x, acc[ai][0][m][0].y, acc[ai][0][m][0].z, acc[ai][0][m][0].w, acc[ai][0][m][1].x, acc[ai][0][m][1].y, acc[ai][0][m][1].z, acc[ai][0][m][1].w};
                    const float a1[8] = {acc[ai][1][m][0].x, acc[ai][1][m][0].y, acc[ai][1][m][0].z, acc[ai][1][m][0].w, acc[ai][1][m][1].x, acc[ai][1][m][1].y, acc[ai][1][m][1].z, acc[ai][1][m][1].w};
                    float o[8];
                    if (kind == 2) { float gs[8]; unpack8_bf16(ld[m][0], gs);
#pragma unroll
                        for (int j = 0; j < 8; ++j) o[j] = gs[j] * a0[j] * sigmoidf_(a1[j]);
                        store8_bf16((bf16_t*)(ws + WS_T1) + row * D + u.pn * 128 + cl8, o);
                    } else {
#pragma unroll
                        for (int bj = 0; bj < 2; ++bj) { const size_t off = row * D + u.pn * 256 + bj * 128 + cl8; float ga[8], t1[8]; const float* a = bj ? a1 : a0;
                            unpack8_bf16(ld[m][2 * bj], ga); unpack8_bf16(ld[m][2 * bj + 1], t1);
#pragma unroll
                            for (int j = 0; j < 8; ++j) o[j] = t1[j] + ga[j] * a[j];
                            store8_bf16((bf16_t*)(ws + WS_MG) + off, o); } }
                }
                asm volatile("" ::: "memory");
            }
            return;
        }
#pragma unroll
        for (int ai = 0; ai < 2; ++ai)
#pragma unroll
            for (int m = 0; m < 4; ++m) {
                if ((PHASE == 7 || PHASE == 8) && u.hm >= 0 && ai != u.hm) continue;
                const int r = ai * 128 + wr * 64 + m * 16 + fr; const size_t row = (size_t)u.pm * 256 + r;
                const float a0[8] = {acc[ai][0][m][0].x, acc[ai][0][m][0].y, acc[ai][0][m][0].z, acc[ai][0][m][0].w, acc[ai][0][m][1].x, acc[ai][0][m][1].y, acc[ai][0][m][1].z, acc[ai][0][m][1].w};
                const float a1[8] = {acc[ai][1][m][0].x, acc[ai][1][m][0].y, acc[ai][1][m][0].z, acc[ai][1][m][0].w, acc[ai][1][m][1].x, acc[ai][1][m][1].y, acc[ai][1][m][1].z, acc[ai][1][m][1].w};
                float o0[8], o1[8];
                if (kind == 1) {
                    const float rsc = rs[r];
#pragma unroll
                    for (int bj = 0; bj < 2; ++bj) {
                        const int hidx = 2 * u.pn + bj; float* o = bj ? o1 : o0; const float* a = bj ? a1 : a0;
                        bf16_t* dst;
                        if (hidx < 4) { dst = (bf16_t*)(ws + WS_U) + row * SSM_W + hidx * 128;
#pragma unroll
                            for (int j = 0; j < 8; ++j) o[j] = a[j] * rsc; }
                        else if (hidx < 12) { dst = (bf16_t*)(ws + WS_Q) + row * D + (hidx - 4) * 128;
#pragma unroll
                            for (int j = 0; j < 8; ++j) o[j] = a[j] * (rsc * QSCALE); }
                        else if (hidx < 14) { dst = (bf16_t*)(ws + WS_KV) + row * 256 + (hidx - 12) * 128;
#pragma unroll
                            for (int j = 0; j < 8; ++j) o[j] = a[j] * rsc; }
                        else { dst = (hidx < 22) ? (bf16_t*)(ws + WS_GS) + row * D + (hidx - 14) * 128 : (bf16_t*)(ws + WS_GA) + row * D + (hidx - 22) * 128;
#pragma unroll
                            for (int j = 0; j < 8; ++j) o[j] = sigmoid_pre(a[j] * (rsc * -LOG2E)); }
                        store8_bf16(dst + cl8, o);
                    }
                } else if (kind == 4) {
#pragma unroll
                    for (int bj = 0; bj < 2; ++bj) { const size_t off = row * D + u.pn * 256 + bj * 128 + cl8; const float* a = bj ? a1 : a0;
                        store8_bf16((bf16_t*)(ws + WS_H1) + off, a);
                        float ag[8];
#pragma unroll
                        for (int j = 0; j < 8; ++j) ag[j] = a[j] * (bj ? cb1[j] : cb0[j]);
                        store8_fp8(ws + WS_H1B + off, ag); }
                } else if (kind == 5) {
                    const float r2 = rs[r];
#pragma unroll
                    for (int j = 0; j < 8; ++j) { float xg = r2 * a0[j] + cb0[j], xl1 = r2 * a1[j] + cb1[j];
                        xg = fminf(xg, 7.0f); xl1 = fminf(fmaxf(xl1, -6.0f), 8.0f);
                        o0[j] = xg * sigmoid_pre(xg * (-1.702f * LOG2E)) * xl1; }
                    store8_fp8(ws + WS_ACT + row * DFF + u.pn * 128 + cl8, o0);
                } else {
                    const float gate = rs[r];
#pragma unroll
                    for (int j = 0; j < 8; ++j) { o0[j] = (gate * YS_SCALE) * (a0[j] + cb0[j]); o1[j] = (gate * YS_SCALE) * (a1[j] + cb1[j]); }
                    unsigned char* dst = ws + WS_YS + row * D + u.pn * 256 + cl8;
                    store8_fp8(dst, o0); store8_fp8(dst + 128, o1);
                }
            }
    }
};

template <int PHASE> DI void gemm_phase(LAS unsigned char* lds, const GemmCtx<PHASE>& S) {
    constexpr bool GATHER = (PHASE == 7);
    constexpr bool F8 = (PHASE == 7 || PHASE == 8);
    constexpr unsigned PITCH = F8 ? 1024u : 2048u;
    using namespace pg8;
    int tid = threadIdx.x; asm volatile("" : "+v"(tid));
    const int wid = __builtin_amdgcn_readfirstlane(tid >> 6), lane = tid & 63, wr = wid >> 2, wc = wid & 3, fr = lane & 15, fq = lane >> 4;
    int Rr[2], Cc[2];
    unsigned oA[2], oB[2];
#pragma unroll
    for (int i = 0; i < 2; ++i) { stage_rc(tid * 16 + i * 8192, Rr[i], Cc[i]); const int Rb = (Rr[i] & ~31) + perm32(Rr[i] & 31);
        oA[i] = (unsigned)(Rr[i] * PITCH + Cc[i] * 2); oB[i] = (unsigned)(Rb * PITCH + Cc[i] * 2); }
    const unsigned ldsw = (unsigned)wid * 1024u;
    const int aoff = lds_byte(wr * 64 + fr, fq * 8), boff = lds_byte(wc * 32 + fr, fq * 8);
    constexpr unsigned HB = 128u * PITCH;
#define PG8_SA(b, h) (((b) * 2 + (h)) * HTB)
#define PG8_SB(b, h) ((4 + (b) * 2 + (h)) * HTB)
#define PG8_STAGE(bufoff, gptr, v0, v1) do { \
        __builtin_amdgcn_global_load_lds((const unsigned*)((gptr) + (v0)), (LAS unsigned*)(lds + (bufoff) + ldsw), 16, 0, 0); \
        __builtin_amdgcn_global_load_lds((const unsigned*)((gptr) + (v1)), (LAS unsigned*)(lds + (bufoff) + ldsw + 8192), 16, 0, 0); } while (0)
#define PG8_LDA(dst, b, h) do { _Pragma("unroll") for (int m = 0; m < 4; ++m) _Pragma("unroll") for (int k = 0; k < 2; ++k) dst[m][k] = *(const LAS bf16x8*)(lds + PG8_SA(b, h) + aoff + m * 2048 + k * 1024); } while (0)
#define PG8_LDB(dst, b, h) do { _Pragma("unroll") for (int n = 0; n < 2; ++n) _Pragma("unroll") for (int k = 0; k < 2; ++k) dst[n][k] = *(const LAS bf16x8*)(lds + PG8_SB(b, h) + boff + n * 2048 + k * 1024); } while (0)
#define PG8_F8FRAG(x) __builtin_bit_cast(v8i_t, __builtin_shufflevector((x)[0], (x)[1], 0, 1, 2, 3, 4, 5, 6, 7, 8, 9, 10, 11, 12, 13, 14, 15))
#define PG8_MMA(ai, bj, At, Bt, Z) do { __builtin_amdgcn_s_setprio(1); _Pragma("unroll") for (int m = 0; m < 4; ++m) _Pragma("unroll") for (int n = 0; n < 2; ++n) { \
        if constexpr (F8) mfma_mx8(acc[ai][bj][m][n], PG8_F8FRAG(Bt[n]), PG8_F8FRAG(At[m]), sc_b, sc_b); \
        else { acc[ai][bj][m][n] = __builtin_amdgcn_mfma_f32_16x16x32_bf16(Bt[n][0], At[m][0], Z ? (f32x4){0.f, 0.f, 0.f, 0.f} : acc[ai][bj][m][n], 0, 0, 0); \
               acc[ai][bj][m][n] = __builtin_amdgcn_mfma_f32_16x16x32_bf16(Bt[n][1], At[m][1], acc[ai][bj][m][n], 0, 0, 0); } } \
        __builtin_amdgcn_s_setprio(0); } while (0)
#define PG8_WAIT_V(n) asm volatile("s_waitcnt vmcnt(" #n ")" ::: "memory")
#define PG8_WAIT_L(n) asm volatile("s_waitcnt lgkmcnt(" #n ")" ::: "memory")
#define PG8_BAR __builtin_amdgcn_s_barrier()
#define PG8_SCHED __builtin_amdgcn_sched_barrier(0)
    int sc_b = MX_SCALE_B; asm volatile("" : "+v"(sc_b));
    GU cur, nxt; int ui = 0;
    if (!S.next(0, cur)) return;
    constexpr bool PEEL = (PHASE == 1 || PHASE == 4);
    f32x4 acc[2][2][4][2];
    if (!PEEL) S.acc_init(acc, cur, wr, wc, fr, fq);
    bf16x8 At[4][2], B0[2][2], B1[2][2];
    const char *cA, *cB; int nt;
    unsigned vA[2][2];
    S.operands(cur, cA, cB, nt);
#define PG8_RS(k) ((LAS float*)(lds + LDS_ROWMETA + ((k) % 3) * 1024))
#define PG8_RT(k) ((LAS int*)(lds + LDS_ROWMETA + 3072 + ((k) % 3) * 1024))
#define PG8_CM(k) ((LAS float*)(lds + LDS_COLMETA + ((k) % 3) * 1024))
    S.rm_issue(cur, 0, lds, tid, wid);
    if (GATHER) { asm volatile("s_waitcnt vmcnt(0)" ::: "memory"); __builtin_amdgcn_s_barrier(); asm volatile("" ::: "memory"); }
#pragma unroll
    for (int h = 0; h < 2; ++h)
#pragma unroll
        for (int i = 0; i < 2; ++i) vA[h][i] = GATHER ? (unsigned)((cur.pos0 + h * 128 + Rr[i] < cur.cnt ? PG8_RT(0)[h * 128 + Rr[i]] : 0) * PITCH + Cc[i] * 2) : oA[i];
    PG8_STAGE(PG8_SB(0, 0), cB, oB[0], oB[1]); PG8_STAGE(PG8_SB(0, 1), cB + HB, oB[0], oB[1]); PG8_STAGE(PG8_SA(0, 0), cA, vA[0][0], vA[0][1]); PG8_STAGE(PG8_SA(0, 1), cA + (GATHER ? 0u : HB), vA[1][0], vA[1][1]);
    if (wr == 1) PG8_BAR;
    PG8_WAIT_V(2); PG8_BAR;
    PG8_STAGE(PG8_SB(1, 0), cB + 128, oB[0], oB[1]); PG8_STAGE(PG8_SA(1, 0), cA + 128, vA[0][0], vA[0][1]); PG8_STAGE(PG8_SB(1, 1), cB + HB + 128, oB[0], oB[1]);
    PG8_WAIT_V(6); PG8_BAR;
    for (;;) {
        const bool has_next = S.next(ui + 1, nxt);
        const char *nA = cA, *nB = cB; int nnt = nt;
        unsigned nvA[2][2];
        if (has_next) { S.operands(nxt, nA, nB, nnt); S.rm_issue(nxt, (ui + 1) % 3, lds, tid, wid); }
#pragma unroll
        for (int h = 0; h < 2; ++h)
#pragma unroll
            for (int i = 0; i < 2; ++i) nvA[h][i] = vA[h][i];
        const bool do0 = !F8 || cur.hm != 1, do1 = !F8 || cur.hm != 0;
        auto trip = [&](int t, auto zt) __attribute__((always_inline)) {
            constexpr bool ZT = decltype(zt)::value;
            const bool last = (t == nt - 2);
            const char* a1 = cA + (size_t)(t + 1) * 128;
            const char* a2 = last ? nA : cA + (size_t)(t + 2) * 128; const char* b2 = last ? nB : cB + (size_t)(t + 2) * 128;
            const char* a3 = a2 + 128; const char* b3 = b2 + 128;
            const char* a1h = GATHER ? a1 : a1 + HB; const char* a2h = GATHER ? a2 : a2 + HB; const char* b2h = b2 + HB; const char* b3h = b3 + HB;
            asm volatile("" : "+s"(a1h), "+s"(a2), "+s"(a2h), "+s"(a3), "+s"(b2), "+s"(b2h), "+s"(b3), "+s"(b3h));
            unsigned wa00 = vA[0][0], wa01 = vA[0][1], wa10 = vA[1][0], wa11 = vA[1][1];
            if (GATHER && last && has_next) {
#pragma unroll
                for (int h = 0; h < 2; ++h)
#pragma unroll
                    for (int i = 0; i < 2; ++i) nvA[h][i] = (unsigned)((nxt.pos0 + h * 128 + Rr[i] < nxt.cnt ? PG8_RT(ui + 1)[h * 128 + Rr[i]] : 0) * PITCH + Cc[i] * 2);
            }
            if (GATHER) { wa00 = last ? nvA[0][0] : wa00; wa01 = last ? nvA[0][1] : wa01; wa10 = last ? nvA[1][0] : wa10; wa11 = last ? nvA[1][1] : wa11; }
            PG8_LDB(B0, 0, 0); PG8_LDB(B1, 0, 1); PG8_SCHED; PG8_LDA(At, 0, 0); PG8_STAGE(PG8_SA(1, 1), a1h, vA[1][0], vA[1][1]);
            PG8_WAIT_V(8); PG8_WAIT_L(0); PG8_BAR; if (do0) { PG8_MMA(0, 0, At, B0, ZT); PG8_MMA(0, 1, At, B1, ZT); } PG8_BAR; PG8_SCHED;
            PG8_LDA(At, 0, 1); PG8_STAGE(PG8_SB(0, 0), b2, oB[0], oB[1]); PG8_STAGE(PG8_SB(0, 1), b2h, oB[0], oB[1]); PG8_STAGE(PG8_SA(0, 0), a2, wa00, wa01);
            PG8_WAIT_V(8); PG8_WAIT_L(0); PG8_BAR; if (do1) { PG8_MMA(1, 0, At, B0, ZT); PG8_MMA(1, 1, At, B1, ZT); } PG8_BAR; PG8_SCHED;
            PG8_LDB(B0, 1, 0); PG8_LDB(B1, 1, 1); PG8_SCHED; PG8_LDA(At, 1, 0); PG8_STAGE(PG8_SA(0, 1), a2h, wa10, wa11);
            PG8_WAIT_V(8); PG8_WAIT_L(0); PG8_BAR; if (do0) { PG8_MMA(0, 0, At, B0, false); PG8_MMA(0, 1, At, B1, false); } PG8_BAR; PG8_SCHED;
            PG8_LDA(At, 1, 1); PG8_STAGE(PG8_SB(1, 0), b3, oB[0], oB[1]); PG8_STAGE(PG8_SB(1, 1), b3h, oB[0], oB[1]); PG8_STAGE(PG8_SA(1, 0), a3, wa00, wa01);
            PG8_WAIT_V(8); PG8_WAIT_L(0); PG8_BAR; if (do1) { PG8_MMA(1, 0, At, B0, false); PG8_MMA(1, 1, At, B1, false); } PG8_BAR; PG8_SCHED;
        };
        if (PEEL) trip(0, std::true_type{});
        for (int t = PEEL ? 2 : 0; t < nt; t += 2) trip(t, std::false_type{});
        if (wr == 0) PG8_BAR;
        S.epilogue(acc, cur, wr, wc, fr, fq, PG8_RS(ui), PG8_CM(ui));
        if (!has_next) break;
        if (!PEEL) S.acc_init(acc, nxt, wr, wc, fr, fq);
        cur = nxt; cA = nA; cB = nB; nt = nnt; ++ui;
#pragma unroll
        for (int h = 0; h < 2; ++h)
#pragma unroll
            for (int i = 0; i < 2; ++i) vA[h][i] = nvA[h][i];
        if (wr == 1) PG8_BAR;
    }
    PG8_WAIT_V(0);
    PG8_BAR;
#undef PG8_RS
#undef PG8_CM
#undef PG8_RT
#undef PG8_SA
#undef PG8_SB
#undef PG8_STAGE
#undef PG8_LDA
#undef PG8_LDB
#undef PG8_MMA
#undef PG8_F8FRAG
#undef PG8_WAIT_V
#undef PG8_WAIT_L
#undef PG8_BAR
#undef PG8_SCHED
}


#define XB_TMO      128
#define XB_XCNT(j)  (256  + 64 * (j))
#define XB_XSUB(j)  (1280 + 64 * (j))
#define XB_XGEN(j)  (2304 + 64 * (j))
#define XB_TOP      3328
#define XB_TOPGEN   3392
#define XCD_BAR_WORDS 3456
#define XB_SPIN_CAP (1u << 20)
constexpr int CW_BAR = 4096;
static_assert((CW_BAR + XCD_BAR_WORDS) * 4 <= (int)CTL_BYTES, "barrier words inside the memset region");
DI unsigned xb_ld(unsigned* p) { return __hip_atomic_load(p, __ATOMIC_RELAXED, __HIP_MEMORY_SCOPE_AGENT); }
DI unsigned xb_add(unsigned* p, unsigned v) { return __hip_atomic_fetch_add(p, v, __ATOMIC_RELAXED, __HIP_MEMORY_SCOPE_AGENT); }
DI unsigned xb_xcc_id() { return (unsigned)__builtin_amdgcn_s_getreg((3 << 11) | 20) & 0xFu; }
#define XB_SPIN(cond, bar) do { unsigned _sp = 0; while (cond) { __builtin_amdgcn_s_sleep(1); \
    if ((++_sp & 255u) == 0u) { if (xb_ld(&(bar)[XB_TMO])) break; if (_sp > XB_SPIN_CAP) { atomicAdd(&(bar)[XB_TMO], 1u); break; } } } } while (0)
struct XcdBarrier { unsigned* bar; unsigned x; volatile LAS unsigned* st; };
DI XcdBarrier xcd_barrier_post(unsigned* bar, volatile LAS unsigned* st) {
    XcdBarrier b; b.bar = bar; b.x = xb_xcc_id(); b.st = st;
    if (threadIdx.x == 0) (void)xb_add(&bar[XB_XCNT(b.x)], 1u);
    return b;
}
DI void xcd_barrier_complete(unsigned* bar, unsigned x, unsigned& nloc, unsigned& nx) {
    const unsigned G = gridDim.x * gridDim.y * gridDim.z;
    unsigned sum, cnt, mine, sp = 0u;
    for (;;) {
        sum = 0u; cnt = 0u; mine = 0u;
#pragma unroll
        for (unsigned j = 0; j < 16; ++j) { const unsigned c = xb_ld(&bar[XB_XCNT(j)]); sum += c; cnt += (c > 0u) ? 1u : 0u; mine = (j == x) ? c : mine; }
        if (sum == G) break;
        __builtin_amdgcn_s_sleep(1);
        if ((++sp & 255u) == 0u) { if (xb_ld(&bar[XB_TMO])) break; if (sp > XB_SPIN_CAP) { atomicAdd(&bar[XB_TMO], 1u); break; } }
    }
    nloc = mine > 0u ? mine : 1u; nx = cnt > 0u ? cnt : 1u;
}
DI void xcd_barrier(const XcdBarrier& b) {
    asm volatile("s_waitcnt vmcnt(0)" ::: "memory");
    __syncthreads();
    if (threadIdx.x == 0) {
        unsigned* bar = b.bar;
        __builtin_amdgcn_s_waitcnt(0);
        unsigned nloc = b.st[0], nx = b.st[1];
        if (nloc == 0u) { xcd_barrier_complete(bar, b.x, nloc, nx); b.st[0] = nloc; b.st[1] = nx; }
        const unsigned old = xb_add(&bar[XB_XSUB(b.x)], 1u);
        const unsigned gen = old / nloc;
        if (old + 1u == (gen + 1u) * nloc) {
            __builtin_amdgcn_fence(__ATOMIC_RELEASE, "agent");
            asm volatile("s_waitcnt vmcnt(0)" ::: "memory");
            const unsigned og = xb_add(&bar[XB_TOP], 1u);
            const unsigned tg = og / nx;
            if (og + 1u == (tg + 1u) * nx) xb_add(&bar[XB_TOPGEN], 1u);
            else XB_SPIN(xb_ld(&bar[XB_TOPGEN]) == tg, bar);
            __builtin_amdgcn_fence(__ATOMIC_ACQUIRE, "agent");
            xb_add(&bar[XB_XGEN(b.x)], 1u);
            asm volatile("s_waitcnt vmcnt(0)" ::: "memory");
        } else {
            XB_SPIN(xb_ld(&bar[XB_XGEN(b.x)]) == gen, bar);
            __builtin_amdgcn_fence(__ATOMIC_ACQUIRE, "agent");
            asm volatile("s_waitcnt vmcnt(0)" ::: "memory");
        }
    }
    __syncthreads();
}

struct TTile { const float* W; const float* gk; bf16_t* Wt; int N, dpitch, k0, n0, pair_half, f8; };
DI void tt_load(const TTile& t, f32x4 (&v)[16], int lane) {
    const int lr = lane >> 4, lc = lane & 15;
#pragma unroll
    for (int j = 0; j < 16; ++j) { const int k = 8 * (j >> 1) + 2 * lr + (j & 1); v[j] = __builtin_nontemporal_load((const f32x4*)(t.W + (size_t)k * t.N + 4 * lc)); }
}
DI void tt_load8(const TTile& t, f32x4 (&v)[16], int lane) {
    const int lr = lane >> 4, lc = lane & 15;
#pragma unroll
    for (int j = 0; j < 16; ++j) { const int k = 16 * (j >> 2) + 4 * lr + (j & 3); v[j] = __builtin_nontemporal_load((const f32x4*)(t.W + (size_t)k * t.N + 4 * lc)); }
}
DI void tt_store8(const TTile& t, f32x4 (&v)[16], LAS unsigned* T, int lane) {
    const int lr = lane >> 4, lc = lane & 15;
#pragma unroll
    for (int j = 0; j < 16; ++j) { const float sc = (t.gk ? t.gk[16 * (j >> 2) + 4 * lr + (j & 3)] : 1.0f) * W8_SCALE; v[j] = v[j] * sc; }
#pragma unroll
    for (int jj = 0; jj < 4; ++jj) {
        T[(4 * lc + 0) * 17 + 4 * jj + lr] = pk4_fp8(v[4 * jj].x, v[4 * jj + 1].x, v[4 * jj + 2].x, v[4 * jj + 3].x);
        T[(4 * lc + 1) * 17 + 4 * jj + lr] = pk4_fp8(v[4 * jj].y, v[4 * jj + 1].y, v[4 * jj + 2].y, v[4 * jj + 3].y);
        T[(4 * lc + 2) * 17 + 4 * jj + lr] = pk4_fp8(v[4 * jj].z, v[4 * jj + 1].z, v[4 * jj + 2].z, v[4 * jj + 3].z);
        T[(4 * lc + 3) * 17 + 4 * jj + lr] = pk4_fp8(v[4 * jj].w, v[4 * jj + 1].w, v[4 * jj + 2].w, v[4 * jj + 3].w);
    }
    asm volatile("s_waitcnt lgkmcnt(0)" ::: "memory");
    const int kc = lane & 3;
#pragma unroll
    for (int j2 = 0; j2 < 4; ++j2) {
        const int nrow = (lane >> 2) + 16 * j2; const int n = t.n0 + nrow; const int row = t.pair_half ? pair_row(n, t.pair_half) : n;
        u32x4 o; o.x = T[nrow * 17 + 4 * kc + 0]; o.y = T[nrow * 17 + 4 * kc + 1]; o.z = T[nrow * 17 + 4 * kc + 2]; o.w = T[nrow * 17 + 4 * kc + 3];
        *(u32x4*)((unsigned char*)t.Wt + (size_t)row * t.dpitch + t.k0 + 16 * kc) = o;
    }
    asm volatile("s_waitcnt lgkmcnt(0)" ::: "memory");
}
DI void tt_store(const TTile& t, f32x4 (&v)[16], LAS unsigned* T, int lane) {
    const int lr = lane >> 4, lc = lane & 15;
    if (t.gk) {
#pragma unroll
        for (int j = 0; j < 16; ++j) { const float sc = t.gk[8 * (j >> 1) + 2 * lr + (j & 1)]; v[j] = v[j] * sc; }
    }
#pragma unroll
    for (int jj = 0; jj < 8; ++jj) {
        T[(4 * lc + 0) * 33 + 4 * jj + lr] = pk2(v[2 * jj].x, v[2 * jj + 1].x);
        T[(4 * lc + 1) * 33 + 4 * jj + lr] = pk2(v[2 * jj].y, v[2 * jj + 1].y);
        T[(4 * lc + 2) * 33 + 4 * jj + lr] = pk2(v[2 * jj].z, v[2 * jj + 1].z);
        T[(4 * lc + 3) * 33 + 4 * jj + lr] = pk2(v[2 * jj].w, v[2 * jj + 1].w);
    }
    asm volatile("s_waitcnt lgkmcnt(0)" ::: "memory");
    const int kc = lane & 7;
#pragma unroll
    for (int j2 = 0; j2 < 8; ++j2) {
        const int nrow = (lane >> 3) + 8 * j2; const int n = t.n0 + nrow; const int row = t.pair_half ? pair_row(n, t.pair_half) : n;
        u32x4 o; o.x = T[nrow * 33 + 4 * kc + 0]; o.y = T[nrow * 33 + 4 * kc + 1]; o.z = T[nrow * 33 + 4 * kc + 2]; o.w = T[nrow * 33 + 4 * kc + 3];
        *(u32x4*)(t.Wt + (size_t)row * t.dpitch + t.k0 + 8 * kc) = o;
    }
    asm volatile("s_waitcnt lgkmcnt(0)" ::: "memory");
}
constexpr int I_UP = NEXP * 16 * 32, I_DN = NEXP * 16 * 16, I_IN = 16 * 60, I_GLU = 8 * 32, I_O = 16 * 16, I_OUT = 16 * 16;
constexpr int P0_NITEMS = I_UP + I_IN + I_GLU + I_O + I_OUT;
DI TTile p0_item(const P* kp, int part, int r) {
    unsigned char* ws = kp->ws; TTile t;
    if (part == 1) { const int e = r >> 8, q = r & 255, kb = q >> 4, nb = q & 15;
        t.W = kp->w_down + (size_t)e * DFF * D + (size_t)kb * 64 * D + nb * 64; t.N = D; t.gk = nullptr; t.Wt = (bf16_t*)(ws + WS_WT_DN + (size_t)e * D * DFF); t.dpitch = DFF; t.k0 = kb * 64; t.n0 = nb * 64; t.pair_half = 0; t.f8 = 1; return t; }
    t.f8 = 0;
    if (r < I_UP) { const int e = r >> 9, q = r & 511, kb = q >> 5, nb = q & 31;
        t.W = kp->w_up + (size_t)e * D * 2048 + (size_t)kb * 64 * 2048 + nb * 64; t.N = 2048; t.gk = nullptr; t.Wt = (bf16_t*)(ws + WS_WT_UP + (size_t)e * 2048 * D); t.dpitch = D; t.k0 = kb * 64; t.n0 = nb * 64; t.pair_half = 1024; t.f8 = 1; return t; }
    r -= I_UP;
    if (r < I_IN) { const int kb = r / 60, nb = r % 60;
        t.W = kp->w_in + (size_t)kb * 64 * INW + nb * 64; t.N = INW; t.gk = kp->mix_g + kb * 64; t.Wt = (bf16_t*)(ws + WS_WT_IN); t.dpitch = D; t.k0 = kb * 64; t.n0 = nb * 64; t.pair_half = 0; return t; }
    r -= I_IN;
    if (r < I_GLU) { const int kb = r >> 5, nb = r & 31;
        t.W = kp->w_glu + (size_t)kb * 64 * 2048 + nb * 64; t.N = 2048; t.gk = nullptr; t.Wt = (bf16_t*)(ws + WS_WT_GLU); t.dpitch = 1024; t.k0 = kb * 64; t.n0 = nb * 64; t.pair_half = 1024; return t; }
    r -= I_GLU;
    const float* src = r < I_O ? kp->w_o : kp->w_out; bf16_t* dst = (bf16_t*)(ws + (r < I_O ? WS_WT_O : WS_WT_OUT)); if (r >= I_O) r -= I_O;
    { const int kb = r >> 4, nb = r & 15; t.W = src + (size_t)kb * 64 * D + nb * 64; t.N = D; t.gk = nullptr; t.Wt = dst; t.dpitch = D; t.k0 = kb * 64; t.n0 = nb * 64; t.pair_half = 0; }
    return t;
}
DI void p0_prep(const P* kp, LAS unsigned char* lds, int gw, int NGW, int wave, int lane, int part) {
    unsigned char* ws = kp->ws;
    LAS unsigned* T = (LAS unsigned*)(lds + wave * 8448);
    {
        const int nitems = part == 1 ? I_DN : P0_NITEMS;
        for (int it = gw; it < nitems; it += NGW) {
            TTile cur = p0_item(kp, part, it); f32x4 v[16];
            if (cur.f8) { tt_load8(cur, v, lane); tt_store8(cur, v, T, lane); } else { tt_load(cur, v, lane); tt_store(cur, v, T, lane); }
        }
    }
    if (part == 1) return;
    {
        const float* x = kp->x; const float* meta = kp->meta; float* rs1 = (float*)(ws + WS_RS1);
        for (int row0 = gw * 4; row0 < MROWS; row0 += NGW * 4) {
            f32x4 v[4][4];
#pragma unroll
            for (int q = 0; q < 4; ++q) { const int row = row0 + q;
                const float* src = row < NTOK ? x + (size_t)row * D : (row < NTOK + NMETA ? meta + (size_t)(row - NTOK) * D : nullptr);
#pragma unroll
                for (int j = 0; j < 4; ++j) v[q][j] = src ? __builtin_nontemporal_load((const f32x4*)(src + j * 256 + lane * 4)) : (f32x4){0.f, 0.f, 0.f, 0.f}; }
#pragma unroll
            for (int q = 0; q < 4; ++q) { const int row = row0 + q; bf16_t* xb = (bf16_t*)(ws + WS_XB) + (size_t)row * D;
                float ss = 0.f;
#pragma unroll
                for (int j = 0; j < 4; ++j) { const f32x4 t = v[q][j]; ss += t.x * t.x + t.y * t.y + t.z * t.z + t.w * t.w;
                    u32x2 o; o.x = pk2(t.x, t.y); o.y = pk2(t.z, t.w); *(u32x2*)(xb + j * 256 + lane * 4) = o; }
                ss = wave_sum(ss);
                if (lane == 0) rs1[row] = rsqrtf(ss * (1.0f / D) + RMS_EPS); }
        }
    }
    for (int gid = gw * 64 + lane; gid < NGRP * 16 * 128; gid += NGW * 64) {
        float* abar = (float*)(ws + WS_ABAR); float* bbar = (float*)(ws + WS_BBAR); float* wr = (float*)(ws + WS_WR);
        if (gid < NGRP * NSTATE) {
            const int g = gid / NSTATE;
            const float are = kp->a_re[gid], aim = kp->a_im[gid], dt = expf(kp->log_dt[g]);
            const float mag = expf(are * dt), ang = aim * dt;
            const float br = mag * cosf(ang), bi = mag * sinf(ang);
            abar[gid * 2] = br; abar[gid * 2 + 1] = bi;
            const float den = are * are + aim * aim, nr = br - 1.0f, ni = bi;
            const float cr = (nr * are + ni * aim) / den, ci = (ni * are - nr * aim) / den;
            bf16_t* BB = (bf16_t*)(ws + WS_BB) + (size_t)g * 128 * 16; const int pch = gid % NSTATE;
            for (int c = 0; c < SSM_GC; ++c) { const float b_r = kp->b_re[gid * SSM_GC + c], b_i = kp->b_im[gid * SSM_GC + c];
                const float vr = cr * b_r - ci * b_i, vi = cr * b_i + ci * b_r;
                bbar[(gid * SSM_GC + c) * 2] = vr; bbar[(gid * SSM_GC + c) * 2 + 1] = vi;
                BB[pch * 16 + c] = f2bf(vr); BB[(64 + pch) * 16 + c] = f2bf(vi); }
        }
        if (gid < NGRP * 16 * 128) { const int comp = gid & 127, c = (gid >> 7) & 15, g = gid >> 11;
            const float v = comp < 64 ? kp->c_re[(g * SSM_GC + c) * NSTATE + comp] : -kp->c_im[(g * SSM_GC + c) * NSTATE + comp - 64];
            ((bf16_t*)(ws + WS_CC))[gid] = f2bf(v); }
        if (gid < D * NEXP) { const float v = kp->router_w[gid] * kp->ffn_g[gid / NEXP]; wr[gid] = v;
            const bf16_t hi = f2bf(v), lo = f2bf(v - bf2f(hi)); const int k = gid / NEXP, e = gid % NEXP;
            ((bf16_t*)(ws + WS_WRH))[e * D + k] = hi; ((bf16_t*)(ws + WS_WRL))[e * D + k] = lo; }
    }
}

DI void xcd_barrier_conv(const XcdBarrier& b, const P* kp, LAS unsigned char* lds, int conv0, int vcu, int wave, int lane) {
    asm volatile("s_waitcnt vmcnt(0)" ::: "memory");
    __syncthreads();
    if (wave != 0) { const int it = conv0 + 7 * vcu + wave - 1;
        if (it < I_DN) { LAS unsigned* T = (LAS unsigned*)(lds + wave * 8448); const TTile t = p0_item(kp, 1, it); f32x4 v[16]; tt_load8(t, v, lane); tt_store8(t, v, T, lane); } }
    if (threadIdx.x == 0) {
        unsigned* bar = b.bar;
        __builtin_amdgcn_s_waitcnt(0);
        unsigned nloc = b.st[0], nx = b.st[1];
        if (nloc == 0u) { xcd_barrier_complete(bar, b.x, nloc, nx); b.st[0] = nloc; b.st[1] = nx; }
        const unsigned old = xb_add(&bar[XB_XSUB(b.x)], 1u);
        const unsigned gen = old / nloc;
        if (old + 1u == (gen + 1u) * nloc) {
            __builtin_amdgcn_fence(__ATOMIC_RELEASE, "agent");
            asm volatile("s_waitcnt vmcnt(0)" ::: "memory");
            const unsigned og = xb_add(&bar[XB_TOP], 1u);
            const unsigned tg = og / nx;
            if (og + 1u == (tg + 1u) * nx) xb_add(&bar[XB_TOPGEN], 1u);
            else XB_SPIN(xb_ld(&bar[XB_TOPGEN]) == tg, bar);
            __builtin_amdgcn_fence(__ATOMIC_ACQUIRE, "agent");
            xb_add(&bar[XB_XGEN(b.x)], 1u);
            asm volatile("s_waitcnt vmcnt(0)" ::: "memory");
        } else {
            XB_SPIN(xb_ld(&bar[XB_XGEN(b.x)]) == gen, bar);
            __builtin_amdgcn_fence(__ATOMIC_ACQUIRE, "agent");
            asm volatile("s_waitcnt vmcnt(0)" ::: "memory");
        }
    }
    __syncthreads();
}

DI void p2_attn_simple(const P* kp, int bid, int G, int tid) {
    unsigned char* ws = kp->ws;
    const bf16_t* Q = (const bf16_t*)(ws + WS_Q); const bf16_t* KV = (const bf16_t*)(ws + WS_KV);
    const int i = tid & 127;
    for (int item = bid * 4 + (tid >> 7); item < BATCH * 32 * NH; item += G * 4) {
        const int n = item & 31, head = (item >> 5) & 15, b = item >> 9, kvh = head / KVREP;
        const int qrow = b * SEQ + n * 128 + i;
        float q[HD], o[HD];
#pragma unroll
        for (int d = 0; d < HD; d += 4) { load4_bf16(Q + (size_t)qrow * D + head * HD + d, q + d); o[d] = o[d + 1] = o[d + 2] = o[d + 3] = 0.f; }
        float m = kp->sinks[head] * LOG2E, l = 1.0f;
        for (int kk = 0; kk < NMETA + 256; ++kk) {
            int krow; bool vis;
            if (kk < NMETA) { krow = NTOK + kk; vis = true; }
            else { const int j = kk - NMETA; const int kpos = (n - 1) * 128 + j; krow = b * SEQ + kpos; vis = (kpos >= 0) && (j > i) && (j <= i + 128); }
            if (!vis) continue;
            const bf16_t* kp2 = KV + (size_t)krow * 256 + kvh * HD; const bf16_t* vp = kp2 + 128;
            float s = 0.f;
#pragma unroll
            for (int d = 0; d < HD; d += 4) { float kf[4]; load4_bf16(kp2 + d, kf); s += q[d] * kf[0] + q[d + 1] * kf[1] + q[d + 2] * kf[2] + q[d + 3] * kf[3]; }
            const float mn = fmaxf(m, s), al = exp2f(m - mn), pe = exp2f(s - mn);
            l = l * al + pe; m = mn;
#pragma unroll
            for (int d = 0; d < HD; d += 4) { float vf[4]; load4_bf16(vp + d, vf); o[d] = o[d] * al + pe * vf[0]; o[d + 1] = o[d + 1] * al + pe * vf[1]; o[d + 2] = o[d + 2] * al + pe * vf[2]; o[d + 3] = o[d + 3] * al + pe * vf[3]; }
        }
        const float inv = 1.0f / l;
        bf16_t* O = (bf16_t*)(ws + WS_ATT) + (size_t)qrow * D + head * HD;
#pragma unroll
        for (int d = 0; d < HD; d += 4) { float v[4] = {o[d] * inv, o[d + 1] * inv, o[d + 2] * inv, o[d + 3] * inv}; store4_bf16(O + d, v); }
    }
}

typedef short s16x4 __attribute__((ext_vector_type(4)));
typedef float f32x16 __attribute__((ext_vector_type(16)));
constexpr int ATT_V_OFF = 36864;
DI int crow16(int r, int h) { return (r & 3) + 8 * (r >> 2) + 4 * h; }
DI s16x4 lds_tr16(LAS unsigned char* p) { return __builtin_bit_cast(s16x4, __builtin_amdgcn_ds_read_tr16_b64_v4i16((LAS s16x4*)p)); }
DI void attn_unit(const P* kp, LAS unsigned char* lds, int b, int n, int kvh, int tid, int wave, int lane) {
    unsigned char* ws = kp->ws;
    const bf16_t* KV = (const bf16_t*)(ws + WS_KV); const bf16_t* Q = (const bf16_t*)(ws + WS_Q);
    __syncthreads();
    for (int c = tid; c < 288 * 8 * 2; c += 512) {
        const int which = c >= 2304 ? 1 : 0, cc = c - which * 2304, row = cc >> 3, ch = cc & 7;
        int src = -1;
        if (row < 16) src = NTOK + row;
        else if (row >= 32) { const int kpos = (n - 1) * 128 + (row - 32); if (kpos >= 0) src = b * SEQ + kpos; }
        u32x4 v = {0u, 0u, 0u, 0u};
        if (src >= 0) v = *(const u32x4*)(KV + (size_t)src * 256 + which * 128 + kvh * HD + ch * 8);
        const int dch = which ? ch : (ch ^ (row & 7));
        *(LAS u32x4*)(lds + which * ATT_V_OFF + row * 128 + dch * 16) = v;
    }
    __syncthreads();
    const int l31 = lane & 31, h = lane >> 5, head = kvh * KVREP + wave;
    const float sink2 = kp->sinks[head] * LOG2E;
    const float NEG = -1.0e30f;
    const int grp = lane >> 4, qq = (lane & 15) >> 2, pp = lane & 3;
    const int vlane = (4 * (grp >> 1) + qq) * 128 + (16 * (grp & 1) + 4 * pp) * 2;
#pragma unroll 1
    for (int qi = 0; qi < 4; ++qi) {
        const int qrow = b * SEQ + n * 128 + qi * 32 + l31;
        bf16x8 qf[4];
#pragma unroll
        for (int ks = 0; ks < 4; ++ks) qf[ks] = __builtin_nontemporal_load((const bf16x8*)(Q + (size_t)qrow * D + head * HD + 16 * ks + 8 * h));
        f32x16 sc[6];
#pragma unroll
        for (int t = 0; t < 6; ++t) {
            const int row0 = (t == 0) ? 0 : 32 + 32 * (qi + t - 1);
            f32x16 acc = {0.f, 0.f, 0.f, 0.f, 0.f, 0.f, 0.f, 0.f, 0.f, 0.f, 0.f, 0.f, 0.f, 0.f, 0.f, 0.f};
            const int krow = row0 + l31;
#pragma unroll
            for (int ks = 0; ks < 4; ++ks) {
                const bf16x8 kf = *(const LAS bf16x8*)(lds + krow * 128 + (((2 * ks + h) ^ (krow & 7)) * 16));
                acc = __builtin_amdgcn_mfma_f32_32x32x16_bf16(kf, qf[ks], acc, 0, 0, 0);
            }
            if (t == 0) {
#pragma unroll
                for (int r = 8; r < 16; ++r) acc[r] = NEG;
            } else {
                if (t == 1) {
#pragma unroll
                    for (int r = 0; r < 16; ++r) acc[r] = (crow16(r, h) > l31) ? acc[r] : NEG;
                }
                if (t == 5) {
#pragma unroll
                    for (int r = 0; r < 16; ++r) acc[r] = (crow16(r, h) <= l31) ? acc[r] : NEG;
                }
                if (n == 0 && qi + t - 1 < 4) {
#pragma unroll
                    for (int r = 0; r < 16; ++r) acc[r] = NEG;
                }
            }
            sc[t] = acc;
        }
        float m = sink2;
#pragma unroll
        for (int t = 0; t < 6; ++t)
#pragma unroll
            for (int r = 0; r < 16; ++r) m = fmaxf(m, sc[t][r]);
        m = fmaxf(m, __shfl_xor(m, 32));
        float lsum = 0.f;
        f32x16 o0 = {0.f, 0.f, 0.f, 0.f, 0.f, 0.f, 0.f, 0.f, 0.f, 0.f, 0.f, 0.f, 0.f, 0.f, 0.f, 0.f}, o1 = o0;
#pragma unroll
        for (int t = 0; t < 6; ++t) {
            const int row0 = (t == 0) ? 0 : 32 + 32 * (qi + t - 1);
            float pe[16];
#pragma unroll
            for (int r = 0; r < 16; ++r) { pe[r] = __builtin_amdgcn_exp2f(sc[t][r] - m); lsum += pe[r]; }
#pragma unroll
            for (int s2 = 0; s2 < 2; ++s2) {
                u32x4 pw; pw.x = pk2(pe[8 * s2], pe[8 * s2 + 1]); pw.y = pk2(pe[8 * s2 + 2], pe[8 * s2 + 3]); pw.z = pk2(pe[8 * s2 + 4], pe[8 * s2 + 5]); pw.w = pk2(pe[8 * s2 + 6], pe[8 * s2 + 7]);
                const bf16x8 pb = __builtin_bit_cast(bf16x8, pw);
                LAS unsigned char* vb = lds + ATT_V_OFF + (row0 + 16 * s2) * 128 + vlane;
                const s16x4 a0l = lds_tr16(vb), a0h = lds_tr16(vb + 8 * 128), a1l = lds_tr16(vb + 64), a1h = lds_tr16(vb + 8 * 128 + 64);
                const bf16x8 va0 = __builtin_shufflevector(a0l, a0h, 0, 1, 2, 3, 4, 5, 6, 7), va1 = __builtin_shufflevector(a1l, a1h, 0, 1, 2, 3, 4, 5, 6, 7);
                o0 = __builtin_amdgcn_mfma_f32_32x32x16_bf16(va0, pb, o0, 0, 0, 0);
                o1 = __builtin_amdgcn_mfma_f32_32x32x16_bf16(va1, pb, o1, 0, 0, 0);
            }
        }
        lsum += __shfl_xor(lsum, 32);
        lsum += __builtin_amdgcn_exp2f(sink2 - m);
        const float inv = __builtin_amdgcn_rcpf(lsum);
        bf16_t* O = (bf16_t*)(ws + WS_ATT) + (size_t)qrow * D + head * HD;
#pragma unroll
        for (int g4 = 0; g4 < 4; ++g4) {
            float v0[4] = {o0[4 * g4] * inv, o0[4 * g4 + 1] * inv, o0[4 * g4 + 2] * inv, o0[4 * g4 + 3] * inv};
            float v1[4] = {o1[4 * g4] * inv, o1[4 * g4 + 1] * inv, o1[4 * g4 + 2] * inv, o1[4 * g4 + 3] * inv};
            store4_bf16(O + 8 * g4 + 4 * h, v0); store4_bf16(O + 32 + 8 * g4 + 4 * h, v1);
        }
    }
}

DI void p3_ssm_simple(const P* kp, LAS unsigned char* lds, int g, int b, int wave, int lane) {
    unsigned char* ws = kp->ws;
    LAS float* sre = (LAS float*)(lds + wave * 512); LAS float* sim = sre + 64;
    const float* abar = (const float*)(ws + WS_ABAR); const float* bbar = (const float*)(ws + WS_BBAR);
    const bf16_t* U = (const bf16_t*)(ws + WS_U); bf16_t* YG = (bf16_t*)(ws + WS_YG);
    const float ar = abar[(g * NSTATE + lane) * 2], ai = abar[(g * NSTATE + lane) * 2 + 1];
    float bbr[16], bbi[16];
#pragma unroll
    for (int c = 0; c < 16; ++c) { bbr[c] = bbar[((g * NSTATE + lane) * 16 + c) * 2]; bbi[c] = bbar[((g * NSTATE + lane) * 16 + c) * 2 + 1]; }
    const int oc = lane & 15, oq = lane >> 4;
    float cr[16], ci[16];
#pragma unroll
    for (int i2 = 0; i2 < 16; ++i2) { cr[i2] = kp->c_re[(g * SSM_GC + oc) * NSTATE + oq * 16 + i2]; ci[i2] = kp->c_im[(g * SSM_GC + oc) * NSTATE + oq * 16 + i2]; }
    const float dsk = kp->dskip[g * SSM_GC + oc];
    float s_r = 0.f, s_i = 0.f;
    u32x4 nx0 = *(const u32x4*)(U + (size_t)NTOK * SSM_W + g * SSM_GC), nx1 = *(const u32x4*)(U + (size_t)NTOK * SSM_W + g * SSM_GC + 8);
    for (int t = 0; t < NMETA + SEQ; ++t) {
        const int row = t < NMETA ? NTOK + t : b * SEQ + (t - NMETA);
        const u32x4 c0 = nx0, c1 = nx1;
        { const int t2 = t + 1 < NMETA + SEQ ? t + 1 : t; const int row2 = t2 < NMETA ? NTOK + t2 : b * SEQ + (t2 - NMETA);
          nx0 = *(const u32x4*)(U + (size_t)row2 * SSM_W + g * SSM_GC); nx1 = *(const u32x4*)(U + (size_t)row2 * SSM_W + g * SSM_GC + 8); }
        float u[16];
        u[0] = __uint_as_float(c0.x << 16); u[1] = __uint_as_float(c0.x & 0xffff0000u); u[2] = __uint_as_float(c0.y << 16); u[3] = __uint_as_float(c0.y & 0xffff0000u);
        u[4] = __uint_as_float(c0.z << 16); u[5] = __uint_as_float(c0.z & 0xffff0000u); u[6] = __uint_as_float(c0.w << 16); u[7] = __uint_as_float(c0.w & 0xffff0000u);
        u[8] = __uint_as_float(c1.x << 16); u[9] = __uint_as_float(c1.x & 0xffff0000u); u[10] = __uint_as_float(c1.y << 16); u[11] = __uint_as_float(c1.y & 0xffff0000u);
        u[12] = __uint_as_float(c1.z << 16); u[13] = __uint_as_float(c1.z & 0xffff0000u); u[14] = __uint_as_float(c1.w << 16); u[15] = __uint_as_float(c1.w & 0xffff0000u);
        float br = 0.f, bi = 0.f;
#pragma unroll
        for (int c = 0; c < 16; ++c) { br += bbr[c] * u[c]; bi += bbi[c] * u[c]; }
        const float nr = ar * s_r - ai * s_i + br, ni = ar * s_i + ai * s_r + bi;
        s_r = nr; s_i = ni;
        if (t >= NMETA) {
            asm volatile("s_waitcnt lgkmcnt(0)" ::: "memory");
            sre[lane] = s_r; sim[lane] = s_i;
            asm volatile("s_waitcnt lgkmcnt(0)" ::: "memory");
            float y = 0.f;
#pragma unroll
            for (int i2 = 0; i2 < 16; ++i2) y += cr[i2] * sre[oq * 16 + i2] - ci[i2] * sim[oq * 16 + i2];
            y += __shfl_xor(y, 16); y += __shfl_xor(y, 32);
            if (lane < 16) { const float yv = y + dsk * u[oc]; YG[(size_t)row * YG_P + g * SSM_GC + oc] = f2bf(gelu_tanh(yv)); }
        }
    }
}

constexpr int SSM_LDS_WAVE = 17920, SSM_BU_P = 72, SSM_S_P = 272, SSM_S_OFF = 9216;
DI float fma_s(float a, float b, float c) { float r; asm("v_fma_f32 %0, %1, %2, %3" : "=v"(r) : "v"(a), "v"(b), "v"(c)); return r; }
DI float ld_agent(const float* p) { return __uint_as_float(__hip_atomic_load((const unsigned*)p, __ATOMIC_RELAXED, __HIP_MEMORY_SCOPE_AGENT)); }
template <bool PASS_C> DI unsigned ssm_span(const P* kp, LAS unsigned char* lw, LAS float* Ew, int b, int g, int w, int lane) {
    unsigned char* ws = kp->ws;
    unsigned hsh = 0u;
    const int l31 = lane & 31, h = lane >> 5, l15 = lane & 15, kg = lane >> 4, odd = lane & 1;
    const bf16_t* U = (const bf16_t*)(ws + WS_U);
    bf16x8 bb[4];
#pragma unroll
    for (int nt = 0; nt < 4; ++nt) bb[nt] = *(const bf16x8*)((const bf16_t*)(ws + WS_BB) + ((size_t)g * 128 + 32 * nt + l31) * 16 + 8 * h);
    bf16x8 cc[4];
    if (PASS_C) {
#pragma unroll
        for (int ks = 0; ks < 4; ++ks) cc[ks] = *(const bf16x8*)((const bf16_t*)(ws + WS_CC) + ((size_t)g * 16 + l15) * 128 + 32 * ks + 8 * kg);
    }
    const float ar = ((const float*)(ws + WS_ABAR))[(g * NSTATE + lane) * 2], ai = ((const float*)(ws + WS_ABAR))[(g * NSTATE + lane) * 2 + 1];
    const float nai = -ai;
    float s_r = 0.f, s_i = 0.f;
    if (PASS_C && w > 0) {
        float pr = ar, pi = ai;
#pragma unroll
        for (int q = 0; q < 9; ++q) { const float nr = pr * pr - pi * pi, ni = 2.f * pr * pi; pr = nr; pi = ni; }
        s_r = Ew[lane]; s_i = Ew[64 + lane];
        for (int j = 1; j < w; ++j) { const float er = Ew[j * 128 + lane], ei = Ew[j * 128 + 64 + lane];
            const float nr = pr * s_r - pi * s_i + er, ni = pr * s_i + pi * s_r + ei; s_r = nr; s_i = ni; }
    }
    const int r_first = (w == 0) ? -1 : 0;
    for (int rd = r_first; rd < 16; ++rd) {
        bf16x8 a;
        if (rd < 0) { a = (bf16x8){0, 0, 0, 0, 0, 0, 0, 0}; if (l31 >= 16) a = *(const bf16x8*)(U + (size_t)(NTOK + l31 - 16) * SSM_W + g * SSM_GC + 8 * h); }
        else a = *(const bf16x8*)(U + (size_t)(b * SEQ + w * 512 + rd * 32 + l31) * SSM_W + g * SSM_GC + 8 * h);
        const f32x16 z16 = {0.f, 0.f, 0.f, 0.f, 0.f, 0.f, 0.f, 0.f, 0.f, 0.f, 0.f, 0.f, 0.f, 0.f, 0.f, 0.f};
#pragma unroll
        for (int nt = 0; nt < 4; ++nt) {
            const f32x16 acc = __builtin_amdgcn_mfma_f32_32x32x16_bf16(a, bb[nt], z16, 0, 0, 0);
#pragma unroll
            for (int q = 0; q < 4; ++q) { u32x2 wv; wv.x = pk2(acc[4 * q], acc[4 * q + 1]); wv.y = pk2(acc[4 * q + 2], acc[4 * q + 3]);
                *(LAS u32x2*)(lw + (32 * nt + l31) * SSM_BU_P + (8 * q + 4 * h) * 2) = wv; }
        }
        asm volatile("s_waitcnt lgkmcnt(0)" ::: "memory");
#pragma unroll
        for (int tb = 0; tb < 8; ++tb) {
            const u32x2 re4 = *(const LAS u32x2*)(lw + lane * SSM_BU_P + tb * 8), im4 = *(const LAS u32x2*)(lw + (64 + lane) * SSM_BU_P + tb * 8);
            const float br[4] = {__uint_as_float(re4.x << 16), __uint_as_float(re4.x & 0xffff0000u), __uint_as_float(re4.y << 16), __uint_as_float(re4.y & 0xffff0000u)};
            const float bi[4] = {__uint_as_float(im4.x << 16), __uint_as_float(im4.x & 0xffff0000u), __uint_as_float(im4.y << 16), __uint_as_float(im4.y & 0xffff0000u)};
#pragma unroll
            for (int q2 = 0; q2 < 2; ++q2) {
                unsigned ri[2];
#pragma unroll
                for (int e = 0; e < 2; ++e) { const int q = 2 * q2 + e;
                    const float nr = fma_s(ar, s_r, fma_s(nai, s_i, br[q])), ni = fma_s(ar, s_i, fma_s(ai, s_r, bi[q])); s_r = nr; s_i = ni;
                    ri[e] = pk2(s_r, s_i); }
                if (PASS_C && rd >= 0) {
                    const int t = tb * 4 + 2 * q2;
                    const unsigned recv = (unsigned)__shfl_xor((int)(odd ? ri[0] : ri[1]), 1);
                    const unsigned dr = odd ? ((recv & 0xffffu) | (ri[1] << 16)) : ((ri[0] & 0xffffu) | (recv << 16));
                    const unsigned di = odd ? ((recv >> 16) | (ri[1] & 0xffff0000u)) : ((ri[0] >> 16) | (recv & 0xffff0000u));
                    const int off = SSM_S_OFF + (t + odd) * SSM_S_P + (lane & ~1) * 2;
                    *(LAS unsigned*)(lw + off) = dr; *(LAS unsigned*)(lw + off + 128) = di;
                }
            }
        }
        if (PASS_C && rd >= 0) {
            asm volatile("s_waitcnt lgkmcnt(0)" ::: "memory");
#pragma unroll
            for (int ntile = 0; ntile < 2; ++ntile) {
                f32x4 y = {0.f, 0.f, 0.f, 0.f};
#pragma unroll
                for (int ks = 0; ks < 4; ++ks) { const bf16x8 sb = *(const LAS bf16x8*)(lw + SSM_S_OFF + (16 * ntile + l15) * SSM_S_P + (32 * ks + 8 * kg) * 2);
                    y = __builtin_amdgcn_mfma_f32_16x16x32_bf16(cc[ks], sb, y, 0, 0, 0); }
                const int row = b * SEQ + w * 512 + rd * 32 + 16 * ntile + l15, ch = g * SSM_GC + 4 * kg;
                float u4[4]; load4_bf16(U + (size_t)row * SSM_W + ch, u4);
                const f32x4 dk = *(const f32x4*)(kp->dskip + ch);
                float o[4] = {gelu_tanh(y.x + dk.x * u4[0]), gelu_tanh(y.y + dk.y * u4[1]), gelu_tanh(y.z + dk.z * u4[2]), gelu_tanh(y.w + dk.w * u4[3])};
                store4_bf16((bf16_t*)(ws + WS_YG) + (size_t)row * YG_P + ch, o);
                hsh = (hsh << 5 | hsh >> 27) ^ pk2(o[0], o[1]); hsh = (hsh << 5 | hsh >> 27) ^ pk2(o[2], o[3]);
            }
        }
        asm volatile("s_waitcnt lgkmcnt(0)" ::: "memory");
    }
    if (!PASS_C && w < 7) { Ew[w * 128 + lane] = s_r; Ew[w * 128 + 64 + lane] = s_i; }
    return hsh;
}

DI float mul_s(float a, float b) { float r; asm("v_mul_f32 %0, %1, %2" : "=v"(r) : "v"(a), "v"(b)); return r; }
DI void cmul(float& xr, float& xi, float ar, float ai) { const float nr = fma_s(xr, ar, -mul_s(xi, ai)), ni = fma_s(xr, ai, mul_s(xi, ar)); xr = nr; xi = ni; }
DI void ssm_end_state(const P* kp, int g, int row0, int nrounds, bool meta, int lane, float (&e)[4]) {
    unsigned char* ws = kp->ws;
    const int l31 = lane & 31, h = lane >> 5;
    const bf16_t* U = (const bf16_t*)(ws + WS_U);
    bf16x8 bb[4];
#pragma unroll
    for (int nt = 0; nt < 4; ++nt) bb[nt] = *(const bf16x8*)((const bf16_t*)(ws + WS_BB) + ((size_t)g * 128 + 32 * nt + l31) * 16 + 8 * h);
    const float* ab = (const float*)(ws + WS_ABAR) + (size_t)g * NSTATE * 2;
    float a1r[2], a1i[2], a4r[2], a4i[2], a32r[2], a32i[2];
#pragma unroll
    for (int c = 0; c < 2; ++c) { a1r[c] = ab[(32 * c + l31) * 2]; a1i[c] = ab[(32 * c + l31) * 2 + 1];
        float pr = a1r[c], pi = a1i[c]; cmul(pr, pi, pr, pi); cmul(pr, pi, pr, pi); a4r[c] = pr; a4i[c] = pi;
        cmul(pr, pi, pr, pi); cmul(pr, pi, pr, pi); cmul(pr, pi, pr, pi); a32r[c] = pr; a32i[c] = pi; }
    float Er[2] = {0.f, 0.f}, Ei[2] = {0.f, 0.f};
    const bf16_t* ubase = U + (size_t)g * SSM_GC + 8 * h;
    bf16x8 an;
    if (meta) { an = (bf16x8){0, 0, 0, 0, 0, 0, 0, 0}; if (l31 >= 16) an = *(const bf16x8*)(ubase + (size_t)(NTOK + l31 - 16) * SSM_W); }
    else an = *(const bf16x8*)(ubase + (size_t)(row0 + l31) * SSM_W);
    for (int rd = meta ? -1 : 0; rd < nrounds; ++rd) {
        const bf16x8 a = an;
        { const int rn = rd + 1 < nrounds ? rd + 1 : rd; an = *(const bf16x8*)(ubase + (size_t)(row0 + rn * 32 + l31) * SSM_W); }
        const f32x16 z16 = {0.f, 0.f, 0.f, 0.f, 0.f, 0.f, 0.f, 0.f, 0.f, 0.f, 0.f, 0.f, 0.f, 0.f, 0.f, 0.f};
#pragma unroll
        for (int c = 0; c < 2; ++c) {
            const f32x16 bre = __builtin_amdgcn_mfma_f32_32x32x16_bf16(a, bb[c], z16, 0, 0, 0);
            const f32x16 bim = __builtin_amdgcn_mfma_f32_32x32x16_bf16(a, bb[2 + c], z16, 0, 0, 0);
            float er = 0.f, ei = 0.f;
#pragma unroll
            for (int q = 0; q < 4; ++q) {
                if (q > 0) cmul(er, ei, a4r[c], a4i[c]);
#pragma unroll
                for (int i = 0; i < 4; ++i) { cmul(er, ei, a1r[c], a1i[c]); er += bre[4 * q + i]; ei += bim[4 * q + i]; }
            }
            const float pr = __shfl_xor(er, 32), pi = __shfl_xor(ei, 32);
            float lo_r = h ? pr : er, lo_i = h ? pi : ei; const float hi_r = h ? er : pr, hi_i = h ? ei : pi;
            cmul(lo_r, lo_i, a4r[c], a4i[c]);
            cmul(Er[c], Ei[c], a32r[c], a32i[c]); Er[c] += lo_r + hi_r; Ei[c] += lo_i + hi_i;
        }
    }
    e[0] = Er[0]; e[1] = Er[1]; e[2] = Ei[0]; e[3] = Ei[1];
}
DI void ssm_span_c(const P* kp, LAS unsigned char* lw, int g, int row0, float s_r, float s_i, int lane) {
    unsigned char* ws = kp->ws;
    const int l31 = lane & 31, h = lane >> 5, l15 = lane & 15, kg = lane >> 4, odd = lane & 1;
    const bf16_t* U = (const bf16_t*)(ws + WS_U);
    bf16x8 bb[4];
#pragma unroll
    for (int nt = 0; nt < 4; ++nt) bb[nt] = *(const bf16x8*)((const bf16_t*)(ws + WS_BB) + ((size_t)g * 128 + 32 * nt + l31) * 16 + 8 * h);
    bf16x8 cc[4];
#pragma unroll
    for (int ks = 0; ks < 4; ++ks) cc[ks] = *(const bf16x8*)((const bf16_t*)(ws + WS_CC) + ((size_t)g * 16 + l15) * 128 + 32 * ks + 8 * kg);
    const float ar = ((const float*)(ws + WS_ABAR))[(g * NSTATE + lane) * 2], ai = ((const float*)(ws + WS_ABAR))[(g * NSTATE + lane) * 2 + 1], nai = -ai;
    const int ch = g * SSM_GC + 4 * kg;
    const f32x4 dk = *(const f32x4*)(kp->dskip + ch);
    bf16x8 an = *(const bf16x8*)(U + (size_t)(row0 + l31) * SSM_W + g * SSM_GC + 8 * h);
    for (int rd = 0; rd < 8; ++rd) {
        const bf16x8 a = an;
        { const int rn = rd + 1 < 8 ? rd + 1 : rd; an = *(const bf16x8*)(U + (size_t)(row0 + rn * 32 + l31) * SSM_W + g * SSM_GC + 8 * h); }
        const u32x2 uw0 = *(const u32x2*)(U + (size_t)(row0 + rd * 32 + l15) * SSM_W + ch), uw1 = *(const u32x2*)(U + (size_t)(row0 + rd * 32 + 16 + l15) * SSM_W + ch);
        const f32x16 z16 = {0.f, 0.f, 0.f, 0.f, 0.f, 0.f, 0.f, 0.f, 0.f, 0.f, 0.f, 0.f, 0.f, 0.f, 0.f, 0.f};
#pragma unroll
        for (int nt = 0; nt < 4; ++nt) {
            const f32x16 acc = __builtin_amdgcn_mfma_f32_32x32x16_bf16(a, bb[nt], z16, 0, 0, 0);
#pragma unroll
            for (int q = 0; q < 4; ++q) { u32x2 wv; wv.x = pk2(acc[4 * q], acc[4 * q + 1]); wv.y = pk2(acc[4 * q + 2], acc[4 * q + 3]);
                *(LAS u32x2*)(lw + (32 * nt + l31) * SSM_BU_P + (8 * q + 4 * h) * 2) = wv; }
        }
        asm volatile("s_waitcnt lgkmcnt(0)" ::: "memory");
#pragma unroll
        for (int tb = 0; tb < 8; ++tb) {
            const u32x2 re4 = *(const LAS u32x2*)(lw + lane * SSM_BU_P + tb * 8), im4 = *(const LAS u32x2*)(lw + (64 + lane) * SSM_BU_P + tb * 8);
            const float br[4] = {__uint_as_float(re4.x << 16), __uint_as_float(re4.x & 0xffff0000u), __uint_as_float(re4.y << 16), __uint_as_float(re4.y & 0xffff0000u)};
            const float bi[4] = {__uint_as_float(im4.x << 16), __uint_as_float(im4.x & 0xffff0000u), __uint_as_float(im4.y << 16), __uint_as_float(im4.y & 0xffff0000u)};
#pragma unroll
            for (int q2 = 0; q2 < 2; ++q2) {
                unsigned ri[2];
#pragma unroll
                for (int e = 0; e < 2; ++e) { const int q = 2 * q2 + e;
                    const float nr = fma_s(ar, s_r, fma_s(nai, s_i, br[q])), ni = fma_s(ar, s_i, fma_s(ai, s_r, bi[q])); s_r = nr; s_i = ni;
                    ri[e] = pk2(s_r, s_i); }
                const int t = tb * 4 + 2 * q2;
                const unsigned recv = (unsigned)__shfl_xor((int)(odd ? ri[0] : ri[1]), 1);
                const unsigned dr = odd ? ((recv & 0xffffu) | (ri[1] << 16)) : ((ri[0] & 0xffffu) | (recv << 16));
                const unsigned di = odd ? ((recv >> 16) | (ri[1] & 0xffff0000u)) : ((ri[0] >> 16) | (recv & 0xffff0000u));
                const int off = SSM_S_OFF + (t + odd) * SSM_S_P + (lane & ~1) * 2;
                *(LAS unsigned*)(lw + off) = dr; *(LAS unsigned*)(lw + off + 128) = di;
            }
        }
        asm volatile("s_waitcnt lgkmcnt(0)" ::: "memory");
#pragma unroll
        for (int ntile = 0; ntile < 2; ++ntile) {
            f32x4 y = {0.f, 0.f, 0.f, 0.f};
#pragma unroll
            for (int ks = 0; ks < 4; ++ks) { const bf16x8 sb = *(const LAS bf16x8*)(lw + SSM_S_OFF + (16 * ntile + l15) * SSM_S_P + (32 * ks + 8 * kg) * 2);
                y = __builtin_amdgcn_mfma_f32_16x16x32_bf16(cc[ks], sb, y, 0, 0, 0); }
            const int row = row0 + rd * 32 + 16 * ntile + l15;
            const u32x2 uw = ntile ? uw1 : uw0;
            const float u4[4] = {__uint_as_float(uw.x << 16), __uint_as_float(uw.x & 0xffff0000u), __uint_as_float(uw.y << 16), __uint_as_float(uw.y & 0xffff0000u)};
            float o[4] = {gelu_tanh(y.x + dk.x * u4[0]), gelu_tanh(y.y + dk.y * u4[1]), gelu_tanh(y.z + dk.z * u4[2]), gelu_tanh(y.w + dk.w * u4[3])};
            store4_bf16((bf16_t*)(ws + WS_YG) + (size_t)row * YG_P + ch, o);
        }
        asm volatile("s_waitcnt lgkmcnt(0)" ::: "memory");
    }
}
DI void ssm_block(const P* kp, LAS unsigned char* lds, int b, int g, int half, int wave, int lane) {
    LAS float* Ew = (LAS float*)(lds + 8 * SSM_LDS_WAVE);
    const int l31 = lane & 31, h = lane >> 5;
    float e[4];
    ssm_end_state(kp, g, b * SEQ + wave * 256, 8, wave == 0, lane, e);
    if (h == 0) { Ew[wave * 128 + l31] = e[0]; Ew[wave * 128 + 32 + l31] = e[1]; Ew[wave * 128 + 64 + l31] = e[2]; Ew[wave * 128 + 96 + l31] = e[3]; }
    if (half) { ssm_end_state(kp, g, b * SEQ + 2048 + wave * 256, 8, false, lane, e);
        if (h == 0) { Ew[(8 + wave) * 128 + l31] = e[0]; Ew[(8 + wave) * 128 + 32 + l31] = e[1]; Ew[(8 + wave) * 128 + 64 + l31] = e[2]; Ew[(8 + wave) * 128 + 96 + l31] = e[3]; } }
    asm volatile("s_waitcnt lgkmcnt(0)" ::: "memory");
    __syncthreads();
    const float ar = ((const float*)(kp->ws + WS_ABAR))[(g * NSTATE + lane) * 2], ai = ((const float*)(kp->ws + WS_ABAR))[(g * NSTATE + lane) * 2 + 1];
    float pr = ar, pi = ai;
#pragma unroll
    for (int q = 0; q < 8; ++q) cmul(pr, pi, pr, pi);
    float s_r = 0.f, s_i = 0.f;
    const int nprev = half * 8 + wave;
    for (int j = 0; j < nprev; ++j) { cmul(s_r, s_i, pr, pi); s_r += Ew[j * 128 + lane]; s_i += Ew[j * 128 + 64 + lane]; }
    ssm_span_c(kp, lds + wave * SSM_LDS_WAVE, g, b * SEQ + half * 2048 + wave * 256, s_r, s_i, lane);
}


DI void p6_route(const P* kp, LAS unsigned char* lds, int bid, int G, int tid, int wave, int lane) {
    unsigned char* ws = kp->ws;
    LAS float* part = (LAS float*)lds; LAS float* ssp = part + 8 * 64 * 33; LAS float* lg = ssp + 8 * 64; LAS unsigned* hist = (LAS unsigned*)(lg + 64 * 33); LAS unsigned* base = hist + 32;
    const float* wr = (const float*)(ws + WS_WR);
    const int l31 = lane & 31, kh = lane >> 5;
    for (int t0 = bid * 64; t0 < NTOK; t0 += G * 64) {
        __syncthreads();
        if (tid < 32) hist[tid] = 0u;
        f32x16 acc0 = {0.f, 0.f, 0.f, 0.f, 0.f, 0.f, 0.f, 0.f, 0.f, 0.f, 0.f, 0.f, 0.f, 0.f, 0.f, 0.f}, acc1 = acc0;
        float ss0 = 0.f, ss1 = 0.f;
        const bf16_t* h0 = (const bf16_t*)(ws + WS_H1) + (size_t)(t0 + l31) * D + wave * 128 + 8 * kh;
        const bf16_t* h1p = h0 + (size_t)32 * D;
        const bf16_t* wh = (const bf16_t*)(ws + WS_WRH) + (size_t)l31 * D + wave * 128 + 8 * kh; const bf16_t* wl = (const bf16_t*)(ws + WS_WRL) + (size_t)l31 * D + wave * 128 + 8 * kh;
#pragma unroll
        for (int st = 0; st < 8; ++st) {
            const bf16x8 x0 = *(const bf16x8*)(h0 + 16 * st), x1 = *(const bf16x8*)(h1p + 16 * st), ah = *(const bf16x8*)(wh + 16 * st), al = *(const bf16x8*)(wl + 16 * st);
#pragma unroll
            for (int j = 0; j < 8; ++j) { const float f0 = bf2f((bf16_t)x0[j]), f1 = bf2f((bf16_t)x1[j]); ss0 += f0 * f0; ss1 += f1 * f1; }
            acc0 = __builtin_amdgcn_mfma_f32_32x32x16_bf16(ah, x0, acc0, 0, 0, 0); acc1 = __builtin_amdgcn_mfma_f32_32x32x16_bf16(ah, x1, acc1, 0, 0, 0);
            acc0 = __builtin_amdgcn_mfma_f32_32x32x16_bf16(al, x0, acc0, 0, 0, 0); acc1 = __builtin_amdgcn_mfma_f32_32x32x16_bf16(al, x1, acc1, 0, 0, 0);
        }
#pragma unroll
        for (int r = 0; r < 16; ++r) { part[(wave * 64 + l31) * 33 + crow16(r, kh)] = acc0[r]; part[(wave * 64 + 32 + l31) * 33 + crow16(r, kh)] = acc1[r]; }
        ss0 += __shfl_xor(ss0, 32); ss1 += __shfl_xor(ss1, 32);
        if (kh == 0) { ssp[wave * 64 + l31] = ss0; ssp[wave * 64 + 32 + l31] = ss1; }
        __syncthreads();
        float r2;
        {
            const int tk = tid & 63, eg = tid >> 6;
            float ssum = 0.f;
#pragma unroll
            for (int w = 0; w < 8; ++w) ssum += ssp[w * 64 + tk];
            r2 = rsqrtf(ssum * (1.0f / D) + RMS_EPS);
#pragma unroll
            for (int e = 4 * eg; e < 4 * eg + 4; ++e) { float a = 0.f;
#pragma unroll
                for (int w = 0; w < 8; ++w) a += part[(w * 64 + tk) * 33 + e];
                lg[tk * 33 + e] = a * r2 + kp->router_b[e]; }
            if (eg == 0) ((float*)(ws + WS_RS2))[t0 + tk] = r2;
        }
        __syncthreads();
        int id[4] = {0, 0, 0, 0}; float gt[4] = {0.f, 0.f, 0.f, 0.f}; unsigned rk[4] = {0u, 0u, 0u, 0u};
        if (tid < 64) {
            float v[4]; unsigned used = 0u;
#pragma unroll
            for (int k = 0; k < TOPK; ++k) { float best = -3.0e38f; int bi = 0;
#pragma unroll
                for (int j = 0; j < NEXP; ++j) { const float x = lg[tid * 33 + j]; const bool take = !((used >> j) & 1u) && x > best; best = take ? x : best; bi = take ? j : bi; }
                used |= 1u << bi; v[k] = best; id[k] = bi; }
            float den = 0.f, ex[4];
#pragma unroll
            for (int k = 0; k < TOPK; ++k) { ex[k] = __expf(v[k] - v[0]); den += ex[k]; }
            const float rden = 1.0f / den;
#pragma unroll
            for (int k = 0; k < TOPK; ++k) { gt[k] = ex[k] * rden; rk[k] = __hip_atomic_fetch_add(&hist[id[k]], 1u, __ATOMIC_RELAXED, __HIP_MEMORY_SCOPE_WORKGROUP); }
        }
        __syncthreads();
        if (tid < 32) base[tid] = atomicAdd((unsigned*)(ws + WS_CTL) + CW_GCOUNT + tid, hist[tid]);
        __syncthreads();
        if (tid < 64) {
            const int tok = t0 + tid;
#pragma unroll
            for (int k = 0; k < TOPK; ++k) { const unsigned pos = base[id[k]] + rk[k];
                ((int*)(ws + WS_LTOK))[(size_t)id[k] * NTOK + pos] = tok;
                ((float*)(ws + WS_LGATE))[(size_t)id[k] * NTOK + pos] = gt[k];
                ((float*)(ws + WS_LRS))[(size_t)id[k] * NTOK + pos] = r2;
                ((int*)(ws + WS_TSLOT))[tok * 4 + k] = (id[k] << 16) | (int)pos; }
        }
    }
}

DI void p9_combine(const P* kp, int gw, int NGW, int lane) {
    unsigned char* ws = kp->ws;
    const unsigned* gcount = (const unsigned*)(ws + WS_CTL) + CW_GCOUNT;
    int mystart;
    { const int c = (int)__hip_atomic_load(gcount + (lane & 31), __ATOMIC_RELAXED, __HIP_MEMORY_SCOPE_AGENT); const int n = ((c + 255) >> 8) * 256; int incl = n;
#pragma unroll
      for (int d = 1; d < 32; d <<= 1) { const int v = __shfl_up(incl, d, 32); if ((lane & 31) >= d) incl += v; }
      mystart = incl - n; }
    const unsigned char* YS8 = ws + WS_YS; const float* fg = kp->final_g; float* out = kp->out;
    for (int tok = gw; tok < NTOK; tok += NGW) {
        const bf16_t* h1 = (const bf16_t*)(ws + WS_H1) + (size_t)tok * D;
        int slot[4];
#pragma unroll
        for (int k = 0; k < 4; ++k) { const int w = ((const int*)(ws + WS_TSLOT))[tok * 4 + k]; slot[k] = __shfl(mystart, w >> 16) + (w & 0xffff); }
        float v[16]; float ss = 0.f;
#pragma unroll
        for (int j = 0; j < 4; ++j) {
            const int c = j * 256 + lane * 4; const u32x2 h = *(const u32x2*)(h1 + c);
            float a[4] = {__uint_as_float(h.x << 16), __uint_as_float(h.x & 0xffff0000u), __uint_as_float(h.y << 16), __uint_as_float(h.y & 0xffff0000u)};
            float ya[4] = {0.f, 0.f, 0.f, 0.f};
#pragma unroll
            for (int k = 0; k < 4; ++k) { const int w = *(const int*)(YS8 + (size_t)slot[k] * D + c);
                ya[0] += __builtin_amdgcn_cvt_f32_fp8(w, 0); ya[1] += __builtin_amdgcn_cvt_f32_fp8(w, 1); ya[2] += __builtin_amdgcn_cvt_f32_fp8(w, 2); ya[3] += __builtin_amdgcn_cvt_f32_fp8(w, 3); }
            a[0] += ya[0] * (1.0f / YS_SCALE); a[1] += ya[1] * (1.0f / YS_SCALE); a[2] += ya[2] * (1.0f / YS_SCALE); a[3] += ya[3] * (1.0f / YS_SCALE);
#pragma unroll
            for (int q = 0; q < 4; ++q) { v[j * 4 + q] = a[q]; ss += a[q] * a[q]; }
        }
        ss = wave_sum(ss);
        const float r = rsqrtf(ss * (1.0f / D) + RMS_EPS);
#pragma unroll
        for (int j = 0; j < 4; ++j) { const int c = j * 256 + lane * 4; const f32x4 g = *(const f32x4*)(fg + c);
            *(f32x4*)(out + (size_t)tok * D + c) = (f32x4){v[j * 4] * r * g.x, v[j * 4 + 1] * r * g.y, v[j * 4 + 2] * r * g.z, v[j * 4 + 3] * r * g.w}; }
    }
}

constexpr int MEGA_LDS = 163840;
constexpr int LDS_MISC = 163328;
static_assert(8 * SSM_LDS_WAVE + 16 * 512 <= LDS_MISC, "SSM LDS map");
__global__ void __launch_bounds__(512, 2) mega(P p_unused, int ph_lo, int ph_hi) {
    extern __shared__ __attribute__((aligned(16))) unsigned char lds_raw[];
    LAS unsigned char* lds = (LAS unsigned char*)lds_raw;
    const P* kp = (const P*)__builtin_amdgcn_kernarg_segment_ptr();
    const int tid = threadIdx.x, lane = tid & 63, wave = __builtin_amdgcn_readfirstlane(tid >> 6);
    const int G = gridDim.x, bid = blockIdx.x;
    const int vcu = (G % 8 == 0) ? (bid % 8) * (G / 8) + bid / 8 : bid;
    const int gw = vcu * 8 + wave, NGW = G * 8;
    volatile LAS unsigned* MISC = (volatile LAS unsigned*)(lds + LDS_MISC);
    for (int i = tid; i < MEGA_LDS / 4; i += 512) ((LAS unsigned*)lds)[i] = 0u;
    __syncthreads();
    const bool fused = (ph_hi - ph_lo) > 1;
    XcdBarrier bar; bar.bar = (unsigned*)(kp->ws + WS_CTL) + CW_BAR; bar.x = 0; bar.st = MISC + 8;
    if (fused) bar = xcd_barrier_post((unsigned*)(kp->ws + WS_CTL) + CW_BAR, MISC + 8);
#define IN(k) (ph_lo <= (k) && (k) < ph_hi)
#define SEAM(k) do { if (IN(k) && IN((k) + 1)) xcd_barrier(bar); } while (0)
#define SEAM_CONV(k, j) do { if (IN(k) && IN((k) + 1)) xcd_barrier_conv(bar, kp, lds, (j) * 7 * G, vcu, wave, lane); } while (0)
#define RUN_GEMM(PH) { GemmCtx<PH> S; S.ws = kp->ws; S.x = kp->x; S.b_up = kp->b_up; S.b_down = kp->b_down; S.fg = kp->ffn_g; S.G = G; S.c = bid; S.T = 0; \
            S.tab = (const LAS int*)(lds + LDS_MOETAB); if (PH >= 7) S.T = moe_table(lds, S.gcount()); \
            gemm_phase<PH>(lds, S); }
    if (IN(0)) p0_prep(kp, lds, gw, NGW, wave, lane, 0);
    SEAM(0);
    if (IN(1)) RUN_GEMM(1)
    SEAM_CONV(1, 0);
    if (IN(2)) {
        for (int u = vcu; u < BATCH * NGRP * 2; u += G) ssm_block(kp, lds, u >> 6, u & 31, (u >> 5) & 1, wave, lane);
        for (int u = vcu; u < BATCH * 32 * 2; u += G) attn_unit(kp, lds, u >> 6, 16 * ((u >> 5) & 1) + ((u & 31) >> 1), u & 1, tid, wave, lane);
        __syncthreads();
        for (int it = 5 * 7 * G + gw; it < I_DN; it += NGW) {
            LAS unsigned* T = (LAS unsigned*)(lds + wave * 8448); const TTile t = p0_item(kp, 1, it); f32x4 v[16]; tt_load8(t, v, lane); tt_store8(t, v, T, lane); }
    }
    SEAM_CONV(2, 1);
    if (IN(4)) RUN_GEMM(4)
    SEAM_CONV(4, 2);
    if (IN(5)) RUN_GEMM(5)
    SEAM_CONV(5, 3);
    if (IN(6)) p6_route(kp, lds, vcu, G, tid, wave, lane);
    SEAM_CONV(6, 4);
    if (IN(7)) RUN_GEMM(7)
    SEAM(7);
    if (IN(8)) RUN_GEMM(8)
    SEAM(8);
    if (IN(9)) p9_combine(kp, gw, NGW, lane);
}

extern "C" void kernel_launch(void* const* d_in, const int* in_sizes, int n_in, void* d_out, int out_size, void* d_ws, size_t ws_size, hipStream_t stream) {
    if (n_in != 24 || out_size != NTOK * D || ws_size < WS_END) { fprintf(stderr, "kernel_launch: unexpected problem (n_in %d out %d ws %zu need %zu)\n", n_in, out_size, ws_size, (size_t)WS_END); return; }
    static int grid = 0;
    if (!grid) {
        int dev = 0, cus = 0;
        if (hipGetDevice(&dev) != hipSuccess || hipDeviceGetAttribute(&cus, hipDeviceAttributeMultiprocessorCount, dev) != hipSuccess) cus = 256;
        if (hipFuncSetAttribute((const void*)mega, hipFuncAttributeMaxDynamicSharedMemorySize, MEGA_LDS) != hipSuccess) fprintf(stderr, "hipFuncSetAttribute failed\n");
        (void)hipGetLastError();
        grid = cus > 0 ? cus : 256;
    }
    P p{};
    const float** pp = (const float**)&p;
    for (int i = 0; i < 24; ++i) pp[i] = (const float*)d_in[i];
    p.out = (float*)d_out; p.ws = (unsigned char*)d_ws;
    (void)hipMemsetAsync((unsigned char*)d_ws + WS_CTL, 0, CTL_BYTES, stream);
#ifndef MK_SPLIT
    mega<<<grid, 512, MEGA_LDS, stream>>>(p, 0, 10);
#else
    for (int ph = 0; ph < 10; ++ph) mega<<<grid, 512, MEGA_LDS, stream>>>(p, ph, ph + 1);
#endif
}
```

```cpp
#include <hip/hip_runtime.h>
#include <cstdio>
#include <cstdint>
#include <type_traits>

typedef unsigned short bf16_t;
typedef float f32x4 __attribute__((ext_vector_type(4)));
typedef unsigned u32x4 __attribute__((ext_vector_type(4)));
typedef unsigned u32x2 __attribute__((ext_vector_type(2)));

constexpr int D = 1024, BATCH = 4, SEQ = 4096, NMETA = 16;
constexpr int NTOK = BATCH * SEQ;
constexpr int MROWS = NTOK + 256;
constexpr int SSM_W = 512, SSM_GC = 16, NGRP = 32, NSTATE = 64, YG_P = 1024;
constexpr int HD = 64, NH = 16, NKVH = 2, KVREP = 8, WIN = 128;
constexpr int INW = 3840;
constexpr int COL_U = 0, COL_Q = 512, COL_K = 1536, COL_V = 1664, COL_GS = 1792, COL_GA = 2816;
constexpr int NEXP = 32, TOPK = 4, DFF = 1024;
constexpr int MAXSLOT = 73728;
constexpr float RMS_EPS = 1e-5f;
constexpr float LOG2E = 1.4426950408889634f;
constexpr float QSCALE = 0.125f * LOG2E;

constexpr size_t al256(size_t x) { return (x + 255) & ~(size_t)255; }
constexpr size_t WS_CTL = 0;
constexpr size_t CTL_BYTES = 1u << 16;
constexpr size_t WS_WT_IN = WS_CTL + CTL_BYTES;
constexpr size_t WS_WT_GLU = WS_WT_IN + al256((size_t)INW * D * 2);
constexpr size_t WS_WT_O = WS_WT_GLU + al256((size_t)2048 * 1024 * 2);
constexpr size_t WS_WT_OUT = WS_WT_O + al256((size_t)D * D * 2);
constexpr size_t WS_WT_UP = WS_WT_OUT + al256((size_t)D * D * 2);
constexpr size_t WS_WT_DN = WS_WT_UP + al256((size_t)NEXP * 2048 * D * 2);
constexpr size_t WS_WR = WS_WT_DN + al256((size_t)NEXP * D * DFF * 2);
constexpr size_t WS_ABAR = WS_WR + al256((size_t)D * NEXP * 4);
constexpr size_t WS_BBAR = WS_ABAR + al256((size_t)NGRP * NSTATE * 2 * 4);
constexpr size_t WS_XB = WS_BBAR + al256((size_t)NGRP * NSTATE * 16 * 2 * 4);
constexpr size_t WS_RS1 = WS_XB + al256((size_t)MROWS * D * 2);
constexpr size_t WS_U = WS_RS1 + al256((size_t)MROWS * 4);
constexpr size_t WS_Q = WS_U + al256((size_t)MROWS * SSM_W * 2);
constexpr size_t WS_KV = WS_Q + al256((size_t)MROWS * D * 2);
constexpr size_t WS_GS = WS_KV + al256((size_t)MROWS * 256 * 2);
constexpr size_t WS_GA = WS_GS + al256((size_t)MROWS * D * 2);
constexpr size_t WS_ATT = WS_GA + al256((size_t)MROWS * D * 2);
constexpr size_t WS_YG = WS_ATT + al256((size_t)NTOK * D * 2);
constexpr size_t WS_T1 = WS_YG + al256((size_t)NTOK * D * 2);
constexpr size_t WS_MG = WS_T1 + al256((size_t)NTOK * D * 2);
constexpr size_t WS_H1 = WS_MG + al256((size_t)NTOK * D * 2);
constexpr size_t WS_H1B = WS_H1 + al256((size_t)NTOK * D * 4);
constexpr size_t WS_RS2 = WS_H1B + al256((size_t)NTOK * D * 2);
constexpr size_t WS_LTOK = WS_RS2 + al256((size_t)NTOK * 4);
constexpr size_t WS_LGATE = WS_LTOK + al256((size_t)NEXP * NTOK * 4);
constexpr size_t WS_TSLOT = WS_LGATE + al256((size_t)NEXP * NTOK * 4);
constexpr size_t WS_ACT = WS_ATT;
constexpr size_t WS_YS = WS_Q;
constexpr size_t WS_BB = WS_TSLOT + al256((size_t)NTOK * 4 * 4);
constexpr size_t WS_CC = WS_BB + al256((size_t)NGRP * 128 * 16 * 2);
constexpr size_t WS_E = WS_CC + al256((size_t)NGRP * 16 * 128 * 2);
constexpr size_t WS_LRS = WS_E + al256((size_t)BATCH * NGRP * 16 * 128 * 4);
constexpr size_t WS_WRH = WS_LRS + al256((size_t)NEXP * NTOK * 4);
constexpr size_t WS_WRL = WS_WRH + al256((size_t)NEXP * D * 2);
static_assert(WS_ATT + (size_t)MAXSLOT * 1024 <= WS_MG, "ACT alias fits in ATT | YG | T1");
static_assert(WS_Q + (size_t)MAXSLOT * 1024 <= WS_GA, "YS alias fits in Q | KV | GS");
constexpr size_t WS_END = WS_WRL + al256((size_t)NEXP * D * 2);
constexpr int CW_GCOUNT = 64;

struct P {
    const float *x, *meta, *mix_g, *w_in, *a_re, *a_im, *log_dt, *b_re, *b_im, *c_re, *c_im, *dskip, *w_glu, *sinks, *w_o, *w_out,
        *ffn_g, *router_w, *router_b, *w_up, *b_up, *w_down, *b_down, *final_g;
    float* out;
    unsigned char* ws;
};

#define DI __device__ __forceinline__
DI int fresh_lane() { int l; asm volatile("v_mbcnt_lo_u32_b32 %0, -1, 0\n\tv_mbcnt_hi_u32_b32 %0, -1, %0" : "=v"(l)); return l; }
DI float bf2f(bf16_t h) { return __uint_as_float(((unsigned)h) << 16); }
DI bf16_t f2bf(float f) { unsigned u = __float_as_uint(f); return (bf16_t)((u + 0x7fffu + ((u >> 16) & 1u)) >> 16); }
typedef float f32x2_t __attribute__((ext_vector_type(2)));
typedef __bf16 bf16x2_t __attribute__((ext_vector_type(2)));
DI unsigned pk2(float lo, float hi) { const f32x2_t v = {lo, hi}; return __builtin_bit_cast(unsigned, __builtin_convertvector(v, bf16x2_t)); }
DI float sigmoidf_(float x) { return __builtin_amdgcn_rcpf(1.0f + __builtin_amdgcn_exp2f(-LOG2E * x)); }
DI float sigmoid_pre(float t) { return __builtin_amdgcn_rcpf(1.0f + __builtin_amdgcn_exp2f(t)); }
DI float gelu_tanh(float x) { const float u2 = 1.5957691216057308f * (x + 0.044715f * x * x * x); return x * __builtin_amdgcn_rcpf(1.0f + __builtin_amdgcn_exp2f(-LOG2E * u2)); }
DI float wave_sum(float v) {
#pragma unroll
    for (int o = 1; o < 64; o <<= 1) v += __shfl_xor(v, o);
    return v;
}
DI int pair_row(int n, int half) { const int j = n < half ? n : n - half; return (j >> 7) * 256 + (n < half ? 0 : 128) + (j & 127); }

DI void store4_bf16(bf16_t* dst, const float* v) { u32x2 o; o.x = pk2(v[0], v[1]); o.y = pk2(v[2], v[3]); *(u32x2*)dst = o; }
DI void load4_bf16(const bf16_t* src, float* v) { const u32x2 o = *(const u32x2*)src; v[0] = __uint_as_float(o.x << 16); v[1] = __uint_as_float(o.x & 0xffff0000u); v[2] = __uint_as_float(o.y << 16); v[3] = __uint_as_float(o.y & 0xffff0000u); }


#define LAS __attribute__((address_space(3)))
typedef short bf16x8 __attribute__((ext_vector_type(8)));
namespace pg8 {
constexpr int BM = 256, BK = 64, HALF = 128, HTB = HALF * BK * 2, STAGE_BYTES = 8 * HTB, NXCD = 8, WGM = 8;
DI int lds_byte(int r, int c) { const int st = (r >> 4) * 2 + (c >> 5), rr = r & 15, cc = c & 31, ob = rr * 64 + cc * 2; return st * 1024 + (ob ^ (((ob >> 9) & 1) << 5)); }
DI void stage_rc(int b, int& R, int& C) { const int st = b / 1024, sb = b % 1024, swz = sb ^ (((sb >> 9) & 1) << 5); R = (st >> 1) * 16 + swz / 64; C = (st & 1) * 32 + (swz % 64) / 2; }
DI int perm32(int rho) { const int n = rho >> 4, i = rho & 15; return 8 * (i >> 2) + 4 * n + (i & 3); }
DI void static_order(int L, int nM, int nN, int& pm, int& pn) {
    const int nwg = nM * nN; int wgid = L;
    { const int q = nwg / NXCD, r = nwg % NXCD, xcd = wgid % NXCD, off = wgid / NXCD; wgid = (xcd < r ? xcd * (q + 1) : r * (q + 1) + (xcd - r) * q) + off; }
    const int nig = WGM * nN, gid = wgid / nig, fm = gid * WGM, gsz = (nM - fm) < WGM ? (nM - fm) : WGM;
    pm = fm + ((wgid % nig) % gsz); pn = (wgid % nig) / gsz;
}
struct GU { int kind, pm, pn, e, pos0, cnt, hm; };
}

typedef int v8i_t __attribute__((ext_vector_type(8)));
DI void mfma_mx8(f32x4& d, v8i_t a, v8i_t b, int sa, int sb) { asm volatile("v_mfma_scale_f32_16x16x128_f8f6f4 %0, %1, %2, %0, %3, %4 op_sel_hi:[0,0,0]" : "+v"(d) : "v"(a), "v"(b), "v"(sa), "v"(sb)); }
DI unsigned pk4_fp8(float a, float b, float c, float d) { int w = 0; w = __builtin_amdgcn_cvt_pk_fp8_f32(a, b, w, false); w = __builtin_amdgcn_cvt_pk_fp8_f32(c, d, w, true); return (unsigned)w; }
DI void store8_fp8(unsigned char* dst, const float* v) { u32x2 o; o.x = pk4_fp8(v[0], v[1], v[2], v[3]); o.y = pk4_fp8(v[4], v[5], v[6], v[7]); *(u32x2*)dst = o; }
constexpr float YS_SCALE = 16.0f;
constexpr float W8_SCALE = 64.0f;
constexpr int MX_SCALE_B = 0x7c7c7c7c;
DI void store8_bf16(bf16_t* dst, const float* v) { u32x4 o; o.x = pk2(v[0], v[1]); o.y = pk2(v[2], v[3]); o.z = pk2(v[4], v[5]); o.w = pk2(v[6], v[7]); *(u32x4*)dst = o; }
DI void unpack8_bf16(const u32x4 o, float* v) {
    v[0] = __uint_as_float(o.x << 16); v[1] = __uint_as_float(o.x & 0xffff0000u); v[2] = __uint_as_float(o.y << 16); v[3] = __uint_as_float(o.y & 0xffff0000u);
    v[4] = __uint_as_float(o.z << 16); v[5] = __uint_as_float(o.z & 0xffff0000u); v[6] = __uint_as_float(o.w << 16); v[7] = __uint_as_float(o.w & 0xffff0000u); }
DI void unpack8_fp8(const u32x2 w, float* v) {
    v[0] = __builtin_amdgcn_cvt_f32_fp8((int)w.x, 0); v[1] = __builtin_amdgcn_cvt_f32_fp8((int)w.x, 1); v[2] = __builtin_amdgcn_cvt_f32_fp8((int)w.x, 2); v[3] = __builtin_amdgcn_cvt_f32_fp8((int)w.x, 3);
    v[4] = __builtin_amdgcn_cvt_f32_fp8((int)w.y, 0); v[5] = __builtin_amdgcn_cvt_f32_fp8((int)w.y, 1); v[6] = __builtin_amdgcn_cvt_f32_fp8((int)w.y, 2); v[7] = __builtin_amdgcn_cvt_f32_fp8((int)w.y, 3); }
DI void load8_bf16(const bf16_t* src, float* v) { const u32x4 o = *(const u32x4*)src;
    v[0] = __uint_as_float(o.x << 16); v[1] = __uint_as_float(o.x & 0xffff0000u); v[2] = __uint_as_float(o.y << 16); v[3] = __uint_as_float(o.y & 0xffff0000u);
    v[4] = __uint_as_float(o.z << 16); v[5] = __uint_as_float(o.z & 0xffff0000u); v[6] = __uint_as_float(o.w << 16); v[7] = __uint_as_float(o.w & 0xffff0000u); }
constexpr int LDS_COLMETA = 131072 + 6144 + 256;
constexpr int LDS_MOETAB = 131072 + 6144;
DI int moe_table(LAS unsigned char* lds, const unsigned* gcount) {
    const int j = threadIdx.x & 31;
    const int cn = (int)__hip_atomic_load(gcount + j, __ATOMIC_RELAXED, __HIP_MEMORY_SCOPE_AGENT), nt = (cn + 255) >> 8;
    int incl = nt;
#pragma unroll
    for (int d = 1; d < 32; d <<= 1) { const int v = __shfl_up(incl, d, 32); if (j >= d) incl += v; }
    LAS int* tab = (LAS int*)(lds + LDS_MOETAB); tab[2 * j] = incl - nt; tab[2 * j + 1] = cn;
    return __builtin_amdgcn_readlane(incl, 31);
}
constexpr int LDS_ROWMETA = 131072;
template <int PHASE> struct GemmCtx {
    static constexpr int phase = PHASE;
    unsigned char* ws; const float* x; const float* b_up; const float* b_down; const float* fg;
    int G, c, T;
    const LAS int* tab;
    DI const unsigned* gcount() const { return (const unsigned*)(ws + WS_CTL) + CW_GCOUNT; }
    DI bool next(int i, pg8::GU& u) const {
        u.e = 0; u.pos0 = 0; u.cnt = 0; u.hm = -1;
        if (phase == 1) { const int L = i * G + c; if (L >= 65 * 15) return false; u.kind = 1;
            if (L < 65 * 8) { pg8::static_order(L, 65, 8, u.pm, u.pn); u.pn += 7; } else pg8::static_order(L - 65 * 8, 65, 7, u.pm, u.pn);
            return true; }
        if (phase == 4) { const int su = (i / 3) * G + c, sub = i % 3; if (su >= 256) return false; int pm, pn2; pg8::static_order(su, 64, 4, pm, pn2);
            u.pm = pm; if (sub < 2) { u.kind = 2; u.pn = 2 * pn2 + sub; } else { u.kind = 3; u.pn = pn2; } return true; }
        if (phase == 5) { const int L = i * G + c; if (L >= 256) return false; u.kind = 4; pg8::static_order(L, 64, 4, u.pm, u.pn); return true; }
        const int nN = phase == 7 ? 8 : 4, U = T * nN, nfull = (U / G) * G, tail = U - nfull; const bool split = tail > 0 && 2 * tail <= G;
        int L = i * G + c;
        if (L >= nfull) { const int j = L - nfull; if (j >= (split ? 2 * tail : tail)) return false; L = nfull + (split ? (j >> 1) : j); u.hm = split ? (j & 1) : -1; }
        u.kind = phase == 7 ? 5 : 6; pg8::static_order(L, T, nN, u.pm, u.pn);
        const int j = threadIdx.x & 31; const int t0 = tab[2 * j], cn = tab[2 * j + 1];
        const unsigned long long hit = __ballot(u.pm >= t0 && u.pm < t0 + ((cn + 255) >> 8));
        const int e = hit ? (int)__builtin_ctzll(hit) : 0;
        u.e = e; u.pos0 = (u.pm - __builtin_amdgcn_readlane(t0, e)) * 256; u.cnt = __builtin_amdgcn_readlane(cn, e);
        if (u.hm < 0 && u.pos0 + 128 >= u.cnt) u.hm = 0;
        return true;
    }
    DI void operands(const pg8::GU& u, const char*& A, const char*& B, int& nt) const {
        nt = 16;
        switch (PHASE == 4 ? u.kind : (PHASE == 1 ? 1 : PHASE == 5 ? 4 : PHASE == 7 ? 5 : 6)) {
        case 1: A = (const char*)(ws + WS_XB); B = (const char*)(ws + WS_WT_IN); break;
        case 2: A = (const char*)(ws + WS_YG); B = (const char*)(ws + WS_WT_GLU); nt = 8; break;
        case 3: A = (const char*)(ws + WS_ATT); B = (const char*)(ws + WS_WT_O); break;
        case 4: A = (const char*)(ws + WS_MG); B = (const char*)(ws + WS_WT_OUT); break;
        case 5: A = (const char*)(ws + WS_H1B); B = (const char*)(ws + WS_WT_UP) + (size_t)u.e * 2048 * D; nt = 8; break;
        default: A = (const char*)(ws + WS_ACT); B = (const char*)(ws + WS_WT_DN) + (size_t)u.e * D * DFF; nt = 8; break;
        }
        constexpr size_t pitch = (PHASE == 7 || PHASE == 8) ? 1024 : 2048;
        B += (size_t)u.pn * 256 * pitch;
        if (PHASE != 7) A += (size_t)u.pm * 256 * pitch;
    }
    DI void rm_issue(const pg8::GU& u, int slot, LAS unsigned char* lds, int tid, int wid) const {
        if (PHASE != 1 && PHASE != 7 && PHASE != 8) return;
        LAS unsigned* rs = (LAS unsigned*)(lds + LDS_ROWMETA + slot * 1024 + (wid & 3) * 256);
        LAS unsigned* rt = (LAS unsigned*)(lds + LDS_ROWMETA + 3072 + slot * 1024 + (wid & 3) * 256);
        LAS unsigned* cm = (LAS unsigned*)(lds + LDS_COLMETA + slot * 1024 + (wid & 3) * 256);
        asm volatile("" : "+v"(tid));
        const unsigned lo = (unsigned)(tid & 255) * 4u;
        if (PHASE == 1) { const char* b = (const char*)(ws + WS_RS1) + (size_t)u.pm * 1024; asm volatile("" : "+s"(b));
            if (wid < 4) __builtin_amdgcn_global_load_lds((const unsigned*)(b + lo), rs, 4, 0, 0); }
        if (PHASE == 7) { const size_t so = ((size_t)u.e * NTOK + u.pos0) * 4; const char* b0 = (const char*)(ws + WS_LTOK) + so; const char* b1 = (const char*)(ws + WS_LRS) + so;
            const char* bb = (const char*)(b_up + (size_t)u.e * 2 * DFF + u.pn * 128); asm volatile("" : "+s"(b0), "+s"(b1), "+s"(bb));
            if (wid < 4) { __builtin_amdgcn_global_load_lds((const unsigned*)(b0 + lo), rt, 4, 0, 0); __builtin_amdgcn_global_load_lds((const unsigned*)(b1 + lo), rs, 4, 0, 0); }
            else { const int i = tid & 255; __builtin_amdgcn_global_load_lds((const unsigned*)(bb + (unsigned)((i >> 7) * DFF + (i & 127)) * 4u), cm, 4, 0, 0); } }
        if (PHASE == 8) { const char* b = (const char*)(ws + WS_LGATE) + ((size_t)u.e * NTOK + u.pos0) * 4; const char* bb = (const char*)(b_down + (size_t)u.e * D + u.pn * 256); asm volatile("" : "+s"(b), "+s"(bb));
            if (wid < 4) __builtin_amdgcn_global_load_lds((const unsigned*)(b + lo), rs, 4, 0, 0);
            else __builtin_amdgcn_global_load_lds((const unsigned*)(bb + lo), cm, 4, 0, 0); }
    }
    DI void acc_init(f32x4 (&acc)[2][2][4][2], const pg8::GU& u, int wr, int wc, int fr, int fq) const {
#pragma unroll
        for (int ai = 0; ai < 2; ++ai)
#pragma unroll
            for (int bj = 0; bj < 2; ++bj)
#pragma unroll
                for (int m = 0; m < 4; ++m)
#pragma unroll
                    for (int n = 0; n < 2; ++n) {
                        if (PHASE == 5) { const size_t row = (size_t)u.pm * 256 + ai * 128 + wr * 64 + m * 16 + fr;
                            const u32x2 q = *(const u32x2*)((const bf16_t*)(ws + WS_XB) + row * D + u.pn * 256 + bj * 128 + wc * 32 + 8 * fq + 4 * n);
                            acc[ai][bj][m][n] = (f32x4){__uint_as_float(q.x << 16), __uint_as_float(q.x & 0xffff0000u), __uint_as_float(q.y << 16), __uint_as_float(q.y & 0xffff0000u)}; }
                        else acc[ai][bj][m][n] = (f32x4){0.f, 0.f, 0.f, 0.f};
                    }
    }
    DI void epilogue(const f32x4 (&acc)[2][2][4][2], const pg8::GU& u, int wr, int wc, int fr, int fq, const LAS float* rs, const LAS float* cm) const {
        const int kind = PHASE == 4 ? u.kind : (PHASE == 1 ? 1 : PHASE == 5 ? 4 : PHASE == 7 ? 5 : 6);
        { const int ln = fresh_lane(); fr = ln & 15; fq = ln >> 4; }
        int cl8 = wc * 32 + 8 * fq;
        float cb0[8], cb1[8];
        if (kind == 4) { const float* gg = fg + u.pn * 256 + cl8;
#pragma unroll
            for (int j = 0; j < 8; ++j) { cb0[j] = gg[j]; cb1[j] = gg[128 + j]; } }
        if (kind == 5 || kind == 6) {
#pragma unroll
            for (int j = 0; j < 8; ++j) { cb0[j] = cm[cl8 + j]; cb1[j] = cm[128 + cl8 + j] + (kind == 5 ? 1.0f : 0.0f); } }
        if (kind == 2) {
            u32x2 lg[2][4];
            {
                int fqo = fq; asm volatile("" : "+v"(fqo));
                const int cw = wc * 32 + 8 * (fqo & ~1);
                u32x4 w4[2][2];
#pragma unroll
                for (int ai = 0; ai < 2; ++ai)
#pragma unroll
                    for (int mp = 0; mp < 2; ++mp) { const size_t row = (size_t)u.pm * 256 + ai * 128 + wr * 64 + (2 * mp + (fqo & 1)) * 16 + fr;
                        w4[ai][mp] = __builtin_nontemporal_load((const u32x4*)(ws + WS_GS + row * D + u.pn * 128 + cw)); }
#pragma unroll
                for (int ai = 0; ai < 2; ++ai)
#pragma unroll
                    for (int mp = 0; mp < 2; ++mp) {
                        const auto sx = __builtin_amdgcn_permlane16_swap(w4[ai][mp].x, w4[ai][mp].z, false, false), sy = __builtin_amdgcn_permlane16_swap(w4[ai][mp].y, w4[ai][mp].w, false, false);
                        lg[ai][2 * mp].x = sx[0]; lg[ai][2 * mp].y = sy[0]; lg[ai][2 * mp + 1].x = sx[1]; lg[ai][2 * mp + 1].y = sy[1]; }
            }
#pragma unroll
            for (int ai = 0; ai < 2; ++ai)
#pragma unroll
                for (int m = 0; m < 4; ++m) { const size_t row = (size_t)u.pm * 256 + ai * 128 + wr * 64 + m * 16 + fr;
                    const float a0[8] = {acc[ai][0][m][0].x, acc[ai][0][m][0].y, acc[ai][0][m][0].z, acc[ai][0][m][0].w, acc[ai][0][m][1].x, acc[ai][0][m][1].y, acc[ai][0][m][1].z, acc[ai][0][m][1].w};
                    const float a1[8] = {acc[ai][1][m][0].x, acc[ai][1][m][0].y, acc[ai][1][m][0].z, acc[ai][1][m][0].w, acc[ai][1][m][1].x, acc[ai][1][m][1].y, acc[ai][1][m][1].z, acc[ai][1][m][1].w};
                    float o[8], gs[8]; unpack8_fp8(lg[ai][m], gs);
#pragma unroll
                    for (int j = 0; j < 8; ++j) o[j] = a0[j] * __builtin_amdgcn_rcpf((1.0f + __builtin_amdgcn_exp2f(gs[j])) * (1.0f + __builtin_amdgcn_exp2f(-LOG2E * a1[j])));
                    store8_bf16((bf16_t*)(ws + WS_T1) + row * D + u.pn * 128 + cl8, o); }
            return;
        }
        if (kind == 2 || kind == 3) {
#pragma unroll
            for (int ai = 0; ai < 2; ++ai) {
                u32x4 ld[4][4];
#pragma unroll
                for (int m = 0; m < 4; ++m) { const size_t row = (size_t)u.pm * 256 + ai * 128 + wr * 64 + m * 16 + fr;
#pragma unroll
                    for (int bj = 0; bj < 2; ++bj) { const size_t off = row * D + u.pn * 256 + bj * 128 + cl8; ld[m][2 * bj + 1] = *(const u32x4*)((const bf16_t*)(ws + WS_T1) + off); } }
                {
                    const int cw = wc * 32 + 8 * (fq & ~1);
#pragma unroll
                    for (int mp = 0; mp < 2; ++mp)
#pragma unroll
                        for (int bj = 0; bj < 2; ++bj) { const size_t rowp = (size_t)u.pm * 256 + ai * 128 + wr * 64 + (2 * mp + (fq & 1)) * 16 + fr;
                            const u32x4 w4 = __builtin_nontemporal_load((const u32x4*)(ws + WS_GA + rowp * D + u.pn * 256 + bj * 128 + cw));
                            const auto sx = __builtin_amdgcn_permlane16_swap(w4.x, w4.z, false, false), sy = __builtin_amdgcn_permlane16_swap(w4.y, w4.w, false, false);
                            ld[2 * mp][2 * bj].x = sx[0]; ld[2 * mp][2 * bj].y = sy[0]; ld[2 * mp + 1][2 * bj].x = sx[1]; ld[2 * mp + 1][2 * bj].y = sy[1]; } }
#pragma unroll
                for (int m = 0; m < 4; ++m) { const size_t row = (size_t)u.pm * 256 + ai * 128 + wr * 64 + m * 16 + fr;
                    const float a0[8] = {acc[ai][0][m][0].x, acc[ai][0][m][0].y, acc[ai][0][m][0].z, acc[ai][0][m][0].w, acc[ai][0][m][1].x, acc[ai][0][m][1].y, acc[ai][0][m][1].z, acc[ai][0][m][1].w};
                    const float a1[8] = {acc[ai][1][m][0].x, acc[ai][1][m][0].y, acc[ai][1][m][0].z, acc[ai][1][m][0].w, acc[ai][1][m][1].x, acc[ai][1][m][1].y, acc[ai][1][m][1].z, acc[ai][1][m][1].w};
                    float o[8];
                    if (kind == 2) { float gs[8]; unpack8_bf16(ld[m][0], gs);
#pragma unroll
                        for (int j = 0; j < 8; ++j) o[j] = gs[j] * a0[j] * sigmoidf_(a1[j]);
                        store8_bf16((bf16_t*)(ws + WS_T1) + row * D + u.pn * 128 + cl8, o);
                    } else {
#pragma unroll
                        for (int bj = 0; bj < 2; ++bj) { const size_t off = row * D + u.pn * 256 + bj * 128 + cl8; float ga[8], t1[8]; const float* a = bj ? a1 : a0;
                            unpack8_fp8((u32x2){ld[m][2 * bj].x, ld[m][2 * bj].y}, ga); unpack8_bf16(ld[m][2 * bj + 1], t1);
#pragma unroll
                            for (int j = 0; j < 8; ++j) o[j] = t1[j] + sigmoid_pre(ga[j]) * a[j];
                            store8_bf16((bf16_t*)(ws + WS_MG) + off, o); } }
                }
                asm volatile("" ::: "memory");
            }
            return;
        }
        if ((PHASE == 7 || PHASE == 8) && (kind == 5 || kind == 6)) {
            const int cw = wc * 32 + 8 * (fq & ~1);
#pragma unroll
            for (int ai = 0; ai < 2; ++ai) {
                if (u.hm >= 0 && ai != u.hm) continue;
#pragma unroll
                for (int mp = 0; mp < 2; ++mp) {
                    u32x2 pk[2][2];
#pragma unroll
                    for (int g = 0; g < 2; ++g) { const int m = 2 * mp + g; const int r = ai * 128 + wr * 64 + m * 16 + fr;
                        const float a0[8] = {acc[ai][0][m][0].x, acc[ai][0][m][0].y, acc[ai][0][m][0].z, acc[ai][0][m][0].w, acc[ai][0][m][1].x, acc[ai][0][m][1].y, acc[ai][0][m][1].z, acc[ai][0][m][1].w};
                        const float a1[8] = {acc[ai][1][m][0].x, acc[ai][1][m][0].y, acc[ai][1][m][0].z, acc[ai][1][m][0].w, acc[ai][1][m][1].x, acc[ai][1][m][1].y, acc[ai][1][m][1].z, acc[ai][1][m][1].w};
                        float o0[8], o1[8];
                        if (kind == 5) { const float r2 = rs[r];
#pragma unroll
                            for (int j = 0; j < 8; ++j) { float xg = r2 * a0[j] + cb0[j], xl1 = r2 * a1[j] + cb1[j];
                                xg = fminf(xg, 7.0f); xl1 = fminf(fmaxf(xl1, -6.0f), 8.0f);
                                o0[j] = xg * sigmoid_pre(xg * (-1.702f * LOG2E)) * xl1; }
                            pk[g][0].x = pk4_fp8(o0[0], o0[1], o0[2], o0[3]); pk[g][0].y = pk4_fp8(o0[4], o0[5], o0[6], o0[7]); pk[g][1] = pk[g][0];
                        } else { const float gate = rs[r];
#pragma unroll
                            for (int j = 0; j < 8; ++j) { o0[j] = (gate * YS_SCALE) * (a0[j] + cb0[j]); o1[j] = (gate * YS_SCALE) * (a1[j] + cb1[j]); }
                            pk[g][0].x = pk4_fp8(o0[0], o0[1], o0[2], o0[3]); pk[g][0].y = pk4_fp8(o0[4], o0[5], o0[6], o0[7]);
                            pk[g][1].x = pk4_fp8(o1[0], o1[1], o1[2], o1[3]); pk[g][1].y = pk4_fp8(o1[4], o1[5], o1[6], o1[7]); }
                    }
                    const size_t row = (size_t)u.pm * 256 + ai * 128 + wr * 64 + (2 * mp + (fq & 1)) * 16 + fr;
#pragma unroll
                    for (int bj = 0; bj < (kind == 5 ? 1 : 2); ++bj) {
                        const auto sx = __builtin_amdgcn_permlane16_swap(pk[0][bj].x, pk[1][bj].x, false, false), sy = __builtin_amdgcn_permlane16_swap(pk[0][bj].y, pk[1][bj].y, false, false);
                        u32x4 ov; ov.x = sx[0]; ov.y = sy[0]; ov.z = sx[1]; ov.w = sy[1];
                        if (kind == 5) *(u32x4*)(ws + WS_ACT + row * DFF + u.pn * 128 + cw) = ov;
                        else *(u32x4*)(ws + WS_YS + row * D + u.pn * 256 + bj * 128 + cw) = ov;
                    }
                }
            }
            return;
        }
#pragma unroll
        for (int ai = 0; ai < 2; ++ai)
#pragma unroll
            for (int m = 0; m < 4; ++m) {
                if ((PHASE == 7 || PHASE == 8) && u.hm >= 0 && ai != u.hm) continue;
                const int r = ai * 128 + wr * 64 + m * 16 + fr; const size_t row = (size_t)u.pm * 256 + r;
                const float a0[8] = {acc[ai][0][m][0].x, acc[ai][0][m][0].y, acc[ai][0][m][0].z, acc[ai][0][m][0].w, acc[ai][0][m][1].x, acc[ai][0][m][1].y, acc[ai][0][m][1].z, acc[ai][0][m][1].w};
                const float a1[8] = {acc[ai][1][m][0].x, acc[ai][1][m][0].y, acc[ai][1][m][0].z, acc[ai][1][m][0].w, acc[ai][1][m][1].x, acc[ai][1][m][1].y, acc[ai][1][m][1].z, acc[ai][1][m][1].w};
                float o0[8], o1[8];
                if (kind == 1) {
                    const float rsc = rs[r];
#pragma unroll
                    for (int bj = 0; bj < 2; ++bj) {
                        const int hidx = 2 * u.pn + bj; float* o = bj ? o1 : o0; const float* a = bj ? a1 : a0;
                        bf16_t* dst;
                        if (hidx < 4) { dst = (bf16_t*)(ws + WS_U) + row * SSM_W + hidx * 128;
#pragma unroll
                            for (int j = 0; j < 8; ++j) o[j] = a[j] * rsc; }
                        else if (hidx < 12) { dst = (bf16_t*)(ws + WS_Q) + row * D + (hidx - 4) * 128;
#pragma unroll
                            for (int j = 0; j < 8; ++j) o[j] = a[j] * (rsc * QSCALE); }
                        else if (hidx < 14) { dst = (bf16_t*)(ws + WS_KV) + row * 256 + (hidx - 12) * 128;
#pragma unroll
                            for (int j = 0; j < 8; ++j) o[j] = a[j] * rsc; }
                        else {
#pragma unroll
                            for (int j = 0; j < 8; ++j) o[j] = a[j] * (rsc * -LOG2E);
                            store8_fp8(ws + (hidx < 22 ? WS_GS : WS_GA) + row * D + (hidx < 22 ? hidx - 14 : hidx - 22) * 128 + cl8, o); continue; }
                        store8_bf16(dst + cl8, o);
                    }
                } else if (kind == 4) {
#pragma unroll
                    for (int bj = 0; bj < 2; ++bj) { const size_t off = row * D + u.pn * 256 + bj * 128 + cl8; const float* a = bj ? a1 : a0;
                        store8_bf16((bf16_t*)(ws + WS_H1) + off, a);
                        float ag[8];
#pragma unroll
                        for (int j = 0; j < 8; ++j) ag[j] = a[j] * (bj ? cb1[j] : cb0[j]);
                        store8_fp8(ws + WS_H1B + off, ag); }
                } else if (kind == 5) {
                    const float r2 = rs[r];
#pragma unroll
                    for (int j = 0; j < 8; ++j) { float xg = r2 * a0[j] + cb0[j], xl1 = r2 * a1[j] + cb1[j];
                        xg = fminf(xg, 7.0f); xl1 = fminf(fmaxf(xl1, -6.0f), 8.0f);
                        o0[j] = xg * sigmoid_pre(xg * (-1.702f * LOG2E)) * xl1; }
                    store8_fp8(ws + WS_ACT + row * DFF + u.pn * 128 + cl8, o0);
                } else {
                    const float gate = rs[r];
#pragma unroll
                    for (int j = 0; j < 8; ++j) { o0[j] = (gate * YS_SCALE) * (a0[j] + cb0[j]); o1[j] = (gate * YS_SCALE) * (a1[j] + cb1[j]); }
                    unsigned char* dst = ws + WS_YS + row * D + u.pn * 256 + cl8;
                    store8_fp8(dst, o0); store8_fp8(dst + 128, o1);
                }
            }
    }
};

template <int PHASE> DI void gemm_phase(LAS unsigned char* lds, const GemmCtx<PHASE>& S) {
    constexpr bool GATHER = (PHASE == 7);
    constexpr bool F8 = (PHASE == 7 || PHASE == 8);
    constexpr unsigned PITCH = F8 ? 1024u : 2048u;
    using namespace pg8;
    int tid = threadIdx.x; asm volatile("" : "+v"(tid));
    const int wid = __builtin_amdgcn_readfirstlane(tid >> 6), lane = tid & 63, wr = wid >> 2, wc = wid & 3, fr = lane & 15, fq = lane >> 4;
    int Rr[2], Cc[2];
    unsigned oA[2], oB[2];
#pragma unroll
    for (int i = 0; i < 2; ++i) { stage_rc(tid * 16 + i * 8192, Rr[i], Cc[i]); const int Rb = (Rr[i] & ~31) + perm32(Rr[i] & 31);
        oA[i] = (unsigned)(Rr[i] * PITCH + Cc[i] * 2); oB[i] = (unsigned)(Rb * PITCH + Cc[i] * 2); }
    const unsigned ldsw = (unsigned)wid * 1024u;
    const int aoff = lds_byte(wr * 64 + fr, fq * 8), boff = lds_byte(wc * 32 + fr, fq * 8);
    constexpr unsigned HB = 128u * PITCH;
#define PG8_SA(b, h) (((b) * 2 + (h)) * HTB)
#define PG8_SB(b, h) ((4 + (b) * 2 + (h)) * HTB)
#define PG8_STAGE(bufoff, gptr, v0, v1) do { \
        __builtin_amdgcn_global_load_lds((const unsigned*)((gptr) + (v0)), (LAS unsigned*)(lds + (bufoff) + ldsw), 16, 0, 0); \
        __builtin_amdgcn_global_load_lds((const unsigned*)((gptr) + (v1)), (LAS unsigned*)(lds + (bufoff) + ldsw + 8192), 16, 0, 0); } while (0)
#define PG8_LDA(dst, b, h) do { _Pragma("unroll") for (int m = 0; m < 4; ++m) _Pragma("unroll") for (int k = 0; k < 2; ++k) dst[m][k] = *(const LAS bf16x8*)(lds + PG8_SA(b, h) + aoff + m * 2048 + k * 1024); } while (0)
#define PG8_LDB(dst, b, h) do { _Pragma("unroll") for (int n = 0; n < 2; ++n) _Pragma("unroll") for (int k = 0; k < 2; ++k) dst[n][k] = *(const LAS bf16x8*)(lds + PG8_SB(b, h) + boff + n * 2048 + k * 1024); } while (0)
#define PG8_F8FRAG(x) __builtin_bit_cast(v8i_t, __builtin_shufflevector((x)[0], (x)[1], 0, 1, 2, 3, 4, 5, 6, 7, 8, 9, 10, 11, 12, 13, 14, 15))
#define PG8_MMA(ai, bj, At, Bt, Z) do { __builtin_amdgcn_s_setprio(1); _Pragma("unroll") for (int m = 0; m < 4; ++m) _Pragma("unroll") for (int n = 0; n < 2; ++n) { \
        if constexpr (F8) { if constexpr (Z) acc[ai][bj][m][n] = __builtin_amdgcn_mfma_scale_f32_16x16x128_f8f6f4(PG8_F8FRAG(Bt[n]), PG8_F8FRAG(At[m]), (f32x4){0.f, 0.f, 0.f, 0.f}, 0, 0, 0, sc_b, 0, sc_b);   \
                            else mfma_mx8(acc[ai][bj][m][n], PG8_F8FRAG(Bt[n]), PG8_F8FRAG(At[m]), sc_b, sc_b); } \
        else { acc[ai][bj][m][n] = __builtin_amdgcn_mfma_f32_16x16x32_bf16(Bt[n][0], At[m][0], Z ? (f32x4){0.f, 0.f, 0.f, 0.f} : acc[ai][bj][m][n], 0, 0, 0); \
               acc[ai][bj][m][n] = __builtin_amdgcn_mfma_f32_16x16x32_bf16(Bt[n][1], At[m][1], acc[ai][bj][m][n], 0, 0, 0); } } \
        __builtin_amdgcn_s_setprio(0); } while (0)
#define PG8_WAIT_V(n) asm volatile("s_waitcnt vmcnt(" #n ")" ::: "memory")
#define PG8_WAIT_L(n) asm volatile("s_waitcnt lgkmcnt(" #n ")" ::: "memory")
#define PG8_BAR __builtin_amdgcn_s_barrier()
#define PG8_SCHED __builtin_amdgcn_sched_barrier(0)
    int sc_b = MX_SCALE_B; asm volatile("" : "+v"(sc_b));
    GU cur, nxt; int ui = 0;
    if (!S.next(0, cur)) return;
    constexpr bool PEEL = (PHASE != 5);
    f32x4 acc[2][2][4][2];
    if (!PEEL) S.acc_init(acc, cur, wr, wc, fr, fq);
    bf16x8 At[4][2], B0[2][2], B1[2][2];
    const char *cA, *cB; int nt;
    unsigned vA[2][2];
    S.operands(cur, cA, cB, nt);
#define PG8_RS(k) ((LAS float*)(lds + LDS_ROWMETA + ((k) % 3) * 1024))
#define PG8_RT(k) ((LAS int*)(lds + LDS_ROWMETA + 3072 + ((k) % 3) * 1024))
#define PG8_CM(k) ((LAS float*)(lds + LDS_COLMETA + ((k) % 3) * 1024))
    S.rm_issue(cur, 0, lds, tid, wid);
    if (GATHER) { asm volatile("s_waitcnt vmcnt(0)" ::: "memory"); __builtin_amdgcn_s_barrier(); asm volatile("" ::: "memory"); }
#pragma unroll
    for (int h = 0; h < 2; ++h)
#pragma unroll
        for (int i = 0; i < 2; ++i) vA[h][i] = GATHER ? (unsigned)((cur.pos0 + h * 128 + Rr[i] < cur.cnt ? PG8_RT(0)[h * 128 + Rr[i]] : 0) * PITCH + Cc[i] * 2) : oA[i];
    PG8_STAGE(PG8_SB(0, 0), cB, oB[0], oB[1]); PG8_STAGE(PG8_SB(0, 1), cB + HB, oB[0], oB[1]); PG8_STAGE(PG8_SA(0, 0), cA, vA[0][0], vA[0][1]); PG8_STAGE(PG8_SA(0, 1), cA + (GATHER ? 0u : HB), vA[1][0], vA[1][1]);
    if (wr == 1) PG8_BAR;
    PG8_WAIT_V(2); PG8_BAR;
    PG8_STAGE(PG8_SB(1, 0), cB + 128, oB[0], oB[1]); PG8_STAGE(PG8_SA(1, 0), cA + 128, vA[0][0], vA[0][1]); PG8_STAGE(PG8_SB(1, 1), cB + HB + 128, oB[0], oB[1]);
    PG8_WAIT_V(6); PG8_BAR;
    for (;;) {
        const bool has_next = S.next(ui + 1, nxt);
        const char *nA = cA, *nB = cB; int nnt = nt;
        unsigned nvA[2][2];
        if (has_next) { S.operands(nxt, nA, nB, nnt); S.rm_issue(nxt, (ui + 1) % 3, lds, tid, wid); }
#pragma unroll
        for (int h = 0; h < 2; ++h)
#pragma unroll
            for (int i = 0; i < 2; ++i) nvA[h][i] = vA[h][i];
        const bool do0 = !F8 || cur.hm != 1, do1 = !F8 || cur.hm != 0;
        auto trip = [&](int t, auto zt) __attribute__((always_inline)) {
            constexpr bool ZT = decltype(zt)::value;
            const bool last = (t == nt - 2);
            const char* a1 = cA + (size_t)(t + 1) * 128;
            const char* a2 = last ? nA : cA + (size_t)(t + 2) * 128; const char* b2 = last ? nB : cB + (size_t)(t + 2) * 128;
            const char* a3 = a2 + 128; const char* b3 = b2 + 128;
            const char* a1h = GATHER ? a1 : a1 + HB; const char* a2h = GATHER ? a2 : a2 + HB; const char* b2h = b2 + HB; const char* b3h = b3 + HB;
            asm volatile("" : "+s"(a1h), "+s"(a2), "+s"(a2h), "+s"(a3), "+s"(b2), "+s"(b2h), "+s"(b3), "+s"(b3h));
            unsigned wa00 = vA[0][0], wa01 = vA[0][1], wa10 = vA[1][0], wa11 = vA[1][1];
            if (GATHER && last && has_next) {
#pragma unroll
                for (int h = 0; h < 2; ++h)
#pragma unroll
                    for (int i = 0; i < 2; ++i) nvA[h][i] = (unsigned)((nxt.pos0 + h * 128 + Rr[i] < nxt.cnt ? PG8_RT(ui + 1)[h * 128 + Rr[i]] : 0) * PITCH + Cc[i] * 2);
            }
            if (GATHER) { wa00 = last ? nvA[0][0] : wa00; wa01 = last ? nvA[0][1] : wa01; wa10 = last ? nvA[1][0] : wa10; wa11 = last ? nvA[1][1] : wa11; }
            PG8_LDB(B0, 0, 0); PG8_LDB(B1, 0, 1); PG8_SCHED; PG8_LDA(At, 0, 0); PG8_STAGE(PG8_SA(1, 1), a1h, vA[1][0], vA[1][1]);
            PG8_WAIT_V(8); PG8_WAIT_L(0); PG8_BAR; if (do0) { PG8_MMA(0, 0, At, B0, ZT); PG8_MMA(0, 1, At, B1, ZT); } PG8_BAR; PG8_SCHED;
            PG8_LDA(At, 0, 1); PG8_STAGE(PG8_SB(0, 0), b2, oB[0], oB[1]); PG8_STAGE(PG8_SB(0, 1), b2h, oB[0], oB[1]); PG8_STAGE(PG8_SA(0, 0), a2, wa00, wa01);
            PG8_WAIT_V(8); PG8_WAIT_L(0); PG8_BAR; if (do1) { PG8_MMA(1, 0, At, B0, ZT); PG8_MMA(1, 1, At, B1, ZT); } PG8_BAR; PG8_SCHED;
            PG8_LDB(B0, 1, 0); PG8_LDB(B1, 1, 1); PG8_SCHED; PG8_LDA(At, 1, 0); PG8_STAGE(PG8_SA(0, 1), a2h, wa10, wa11);
            PG8_WAIT_V(8); PG8_WAIT_L(0); PG8_BAR; if (do0) { PG8_MMA(0, 0, At, B0, false); PG8_MMA(0, 1, At, B1, false); } PG8_BAR; PG8_SCHED;
            PG8_LDA(At, 1, 1); PG8_STAGE(PG8_SB(1, 0), b3, oB[0], oB[1]); PG8_STAGE(PG8_SB(1, 1), b3h, oB[0], oB[1]); PG8_STAGE(PG8_SA(1, 0), a3, wa00, wa01);
            PG8_WAIT_V(8); PG8_WAIT_L(0); PG8_BAR; if (do1) { PG8_MMA(1, 0, At, B0, false); PG8_MMA(1, 1, At, B1, false); } PG8_BAR; PG8_SCHED;
        };
        if (PEEL) trip(0, std::true_type{});
        for (int t = PEEL ? 2 : 0; t < nt; t += 2) trip(t, std::false_type{});
        if (wr == 0) PG8_BAR;
        S.epilogue(acc, cur, wr, wc, fr, fq, PG8_RS(ui), PG8_CM(ui));
        if (!has_next) break;
        if (!PEEL) S.acc_init(acc, nxt, wr, wc, fr, fq);
        cur = nxt; cA = nA; cB = nB; nt = nnt; ++ui;
#pragma unroll
        for (int h = 0; h < 2; ++h)
#pragma unroll
            for (int i = 0; i < 2; ++i) vA[h][i] = nvA[h][i];
        if (wr == 1) PG8_BAR;
    }
    PG8_WAIT_V(0);
    PG8_BAR;
#undef PG8_RS
#undef PG8_CM
#undef PG8_RT
#undef PG8_SA
#undef PG8_SB
#undef PG8_STAGE
#undef PG8_LDA
#undef PG8_LDB
#undef PG8_MMA
#undef PG8_F8FRAG
#undef PG8_WAIT_V
#undef PG8_WAIT_L
#undef PG8_BAR
#undef PG8_SCHED
}


#define XB_TMO      128
#define XB_XCNT(j)  (256  + 64 * (j))
#define XB_XSUB(j)  (1280 + 64 * (j))
#define XB_XGEN(j)  (2304 + 64 * (j))
#define XB_TOP      3328
#define XB_TOPGEN   3392
#define XCD_BAR_WORDS 3456
#define XB_SPIN_CAP (1u << 20)
constexpr int CW_BAR = 4096;
static_assert((CW_BAR + XCD_BAR_WORDS) * 4 <= (int)CTL_BYTES, "barrier words inside the memset region");
DI unsigned xb_ld(unsigned* p) { return __hip_atomic_load(p, __ATOMIC_RELAXED, __HIP_MEMORY_SCOPE_AGENT); }
DI unsigned xb_add(unsigned* p, unsigned v) { return __hip_atomic_fetch_add(p, v, __ATOMIC_RELAXED, __HIP_MEMORY_SCOPE_AGENT); }
DI unsigned xb_xcc_id() { return (unsigned)__builtin_amdgcn_s_getreg((3 << 11) | 20) & 0xFu; }
#define XB_SPIN(cond, bar) do { unsigned _sp = 0; while (cond) { __builtin_amdgcn_s_sleep(1); \
    if ((++_sp & 255u) == 0u) { if (xb_ld(&(bar)[XB_TMO])) break; if (_sp > XB_SPIN_CAP) { atomicAdd(&(bar)[XB_TMO], 1u); break; } } } } while (0)
struct XcdBarrier { unsigned* bar; unsigned x; volatile LAS unsigned* st; };
DI XcdBarrier xcd_barrier_post(unsigned* bar, volatile LAS unsigned* st) {
    XcdBarrier b; b.bar = bar; b.x = xb_xcc_id(); b.st = st;
    if (threadIdx.x == 0) (void)xb_add(&bar[XB_XCNT(b.x)], 1u);
    return b;
}
DI void xcd_barrier_complete(unsigned* bar, unsigned x, unsigned& nloc, unsigned& nx) {
    const unsigned G = gridDim.x * gridDim.y * gridDim.z;
    unsigned sum, cnt, mine, sp = 0u;
    for (;;) {
        sum = 0u; cnt = 0u; mine = 0u;
#pragma unroll
        for (unsigned j = 0; j < 16; ++j) { const unsigned c = xb_ld(&bar[XB_XCNT(j)]); sum += c; cnt += (c > 0u) ? 1u : 0u; mine = (j == x) ? c : mine; }
        if (sum == G) break;
        __builtin_amdgcn_s_sleep(1);
        if ((++sp & 255u) == 0u) { if (xb_ld(&bar[XB_TMO])) break; if (sp > XB_SPIN_CAP) { atomicAdd(&bar[XB_TMO], 1u); break; } }
    }
    nloc = mine > 0u ? mine : 1u; nx = cnt > 0u ? cnt : 1u;
}
DI void xcd_barrier(const XcdBarrier& b) {
    asm volatile("s_waitcnt vmcnt(0)" ::: "memory");
    __syncthreads();
    if (threadIdx.x == 0) {
        unsigned* bar = b.bar;
        __builtin_amdgcn_s_waitcnt(0);
        unsigned nloc = b.st[0], nx = b.st[1];
        if (nloc == 0u) { xcd_barrier_complete(bar, b.x, nloc, nx); b.st[0] = nloc; b.st[1] = nx; }
        const unsigned old = xb_add(&bar[XB_XSUB(b.x)], 1u);
        const unsigned gen = old / nloc;
        if (old + 1u == (gen + 1u) * nloc) {
            __builtin_amdgcn_fence(__ATOMIC_RELEASE, "agent");
            asm volatile("s_waitcnt vmcnt(0)" ::: "memory");
            const unsigned og = xb_add(&bar[XB_TOP], 1u);
            const unsigned tg = og / nx;
            if (og + 1u == (tg + 1u) * nx) {
#pragma unroll
                for (int j = 0; j < 16; ++j) (void)xb_add(&bar[XB_XGEN(j)], 1u);
            } else XB_SPIN(xb_ld(&bar[XB_XGEN(b.x)]) == gen, bar);
            __builtin_amdgcn_fence(__ATOMIC_ACQUIRE, "agent");
            asm volatile("s_waitcnt vmcnt(0)" ::: "memory");
        } else {
            XB_SPIN(xb_ld(&bar[XB_XGEN(b.x)]) == gen, bar);
            __builtin_amdgcn_fence(__ATOMIC_ACQUIRE, "agent");
            asm volatile("s_waitcnt vmcnt(0)" ::: "memory");
        }
    }
    __syncthreads();
}

struct TTile { const float* W; const float* gk; bf16_t* Wt; int N, dpitch, k0, n0, pair_half, f8; };
DI void tt_load(const TTile& t, f32x4 (&v)[16], int lane) {
    const int lr = lane >> 4, lc = lane & 15;
#pragma unroll
    for (int j = 0; j < 16; ++j) { const int k = 8 * (j >> 1) + 2 * lr + (j & 1); v[j] = __builtin_nontemporal_load((const f32x4*)(t.W + (size_t)k * t.N + 4 * lc)); }
}
DI void tt_load8(const TTile& t, f32x4 (&v)[16], int lane) {
    const int lr = lane >> 4, lc = lane & 15;
#pragma unroll
    for (int j = 0; j < 16; ++j) { const int k = 16 * (j >> 2) + 4 * lr + (j & 3); v[j] = __builtin_nontemporal_load((const f32x4*)(t.W + (size_t)k * t.N + 4 * lc)); }
}
DI void tt_store8(const TTile& t, f32x4 (&v)[16], LAS unsigned* T, int lane) {
    const int lr = lane >> 4, lc = lane & 15;
#pragma unroll
    for (int j = 0; j < 16; ++j) { const float sc = (t.gk ? t.gk[16 * (j >> 2) + 4 * lr + (j & 3)] : 1.0f) * W8_SCALE; v[j] = v[j] * sc; }
#pragma unroll
    for (int jj = 0; jj < 4; ++jj) {
        T[(4 * lc + 0) * 17 + 4 * jj + lr] = pk4_fp8(v[4 * jj].x, v[4 * jj + 1].x, v[4 * jj + 2].x, v[4 * jj + 3].x);
        T[(4 * lc + 1) * 17 + 4 * jj + lr] = pk4_fp8(v[4 * jj].y, v[4 * jj + 1].y, v[4 * jj + 2].y, v[4 * jj + 3].y);
        T[(4 * lc + 2) * 17 + 4 * jj + lr] = pk4_fp8(v[4 * jj].z, v[4 * jj + 1].z, v[4 * jj + 2].z, v[4 * jj + 3].z);
        T[(4 * lc + 3) * 17 + 4 * jj + lr] = pk4_fp8(v[4 * jj].w, v[4 * jj + 1].w, v[4 * jj + 2].w, v[4 * jj + 3].w);
    }
    asm volatile("s_waitcnt lgkmcnt(0)" ::: "memory");
    const int kc = lane & 3;
#pragma unroll
    for (int j2 = 0; j2 < 4; ++j2) {
        const int nrow = (lane >> 2) + 16 * j2; const int n = t.n0 + nrow; const int row = t.pair_half ? pair_row(n, t.pair_half) : n;
        u32x4 o; o.x = T[nrow * 17 + 4 * kc + 0]; o.y = T[nrow * 17 + 4 * kc + 1]; o.z = T[nrow * 17 + 4 * kc + 2]; o.w = T[nrow * 17 + 4 * kc + 3];
        *(u32x4*)((unsigned char*)t.Wt + (size_t)row * t.dpitch + t.k0 + 16 * kc) = o;
    }
    asm volatile("s_waitcnt lgkmcnt(0)" ::: "memory");
}
DI void tt_store(const TTile& t, f32x4 (&v)[16], LAS unsigned* T, int lane) {
    const int lr = lane >> 4, lc = lane & 15;
    if (t.gk) {
#pragma unroll
        for (int j = 0; j < 16; ++j) { const float sc = t.gk[8 * (j >> 1) + 2 * lr + (j & 1)]; v[j] = v[j] * sc; }
    }
#pragma unroll
    for (int jj = 0; jj < 8; ++jj) {
        T[(4 * lc + 0) * 33 + 4 * jj + lr] = pk2(v[2 * jj].x, v[2 * jj + 1].x);
        T[(4 * lc + 1) * 33 + 4 * jj + lr] = pk2(v[2 * jj].y, v[2 * jj + 1].y);
        T[(4 * lc + 2) * 33 + 4 * jj + lr] = pk2(v[2 * jj].z, v[2 * jj + 1].z);
        T[(4 * lc + 3) * 33 + 4 * jj + lr] = pk2(v[2 * jj].w, v[2 * jj + 1].w);
    }
    asm volatile("s_waitcnt lgkmcnt(0)" ::: "memory");
    const int kc = lane & 7;
#pragma unroll
    for (int j2 = 0; j2 < 8; ++j2) {
        const int nrow = (lane >> 3) + 8 * j2; const int n = t.n0 + nrow; const int row = t.pair_half ? pair_row(n, t.pair_half) : n;
        u32x4 o; o.x = T[nrow * 33 + 4 * kc + 0]; o.y = T[nrow * 33 + 4 * kc + 1]; o.z = T[nrow * 33 + 4 * kc + 2]; o.w = T[nrow * 33 + 4 * kc + 3];
        *(u32x4*)(t.Wt + (size_t)row * t.dpitch + t.k0 + 8 * kc) = o;
    }
    asm volatile("s_waitcnt lgkmcnt(0)" ::: "memory");
}
constexpr int I_UP = NEXP * 16 * 32, I_DN = NEXP * 16 * 16, I_IN = 16 * 60, I_GLU = 8 * 32, I_O = 16 * 16, I_OUT = 16 * 16;
constexpr int P0_NITEMS = I_UP + I_IN + I_GLU + I_O + I_OUT;
DI TTile p0_item(const P* kp, int part, int r) {
    unsigned char* ws = kp->ws; TTile t;
    if (part == 1) { const int e = r >> 8, q = r & 255, kb = q >> 4, nb = q & 15;
        t.W = kp->w_down + (size_t)e * DFF * D + (size_t)kb * 64 * D + nb * 64; t.N = D; t.gk = nullptr; t.Wt = (bf16_t*)(ws + WS_WT_DN + (size_t)e * D * DFF); t.dpitch = DFF; t.k0 = kb * 64; t.n0 = nb * 64; t.pair_half = 0; t.f8 = 1; return t; }
    t.f8 = 0;
    if (r < I_UP) { const int e = r >> 9, q = r & 511, kb = q >> 5, nb = q & 31;
        t.W = kp->w_up + (size_t)e * D * 2048 + (size_t)kb * 64 * 2048 + nb * 64; t.N = 2048; t.gk = nullptr; t.Wt = (bf16_t*)(ws + WS_WT_UP + (size_t)e * 2048 * D); t.dpitch = D; t.k0 = kb * 64; t.n0 = nb * 64; t.pair_half = 1024; t.f8 = 1; return t; }
    r -= I_UP;
    if (r < I_IN) { const int kb = r / 60, nb = r % 60;
        t.W = kp->w_in + (size_t)kb * 64 * INW + nb * 64; t.N = INW; t.gk = kp->mix_g + kb * 64; t.Wt = (bf16_t*)(ws + WS_WT_IN); t.dpitch = D; t.k0 = kb * 64; t.n0 = nb * 64; t.pair_half = 0; return t; }
    r -= I_IN;
    if (r < I_GLU) { const int kb = r >> 5, nb = r & 31;
        t.W = kp->w_glu + (size_t)kb * 64 * 2048 + nb * 64; t.N = 2048; t.gk = nullptr; t.Wt = (bf16_t*)(ws + WS_WT_GLU); t.dpitch = 1024; t.k0 = kb * 64; t.n0 = nb * 64; t.pair_half = 1024; return t; }
    r -= I_GLU;
    const float* src = r < I_O ? kp->w_o : kp->w_out; bf16_t* dst = (bf16_t*)(ws + (r < I_O ? WS_WT_O : WS_WT_OUT)); if (r >= I_O) r -= I_O;
    { const int kb = r >> 4, nb = r & 15; t.W = src + (size_t)kb * 64 * D + nb * 64; t.N = D; t.gk = nullptr; t.Wt = dst; t.dpitch = D; t.k0 = kb * 64; t.n0 = nb * 64; t.pair_half = 0; }
    return t;
}
DI void p0_prep(const P* kp, LAS unsigned char* lds, int gw, int NGW, int wave, int lane, int part) {
    unsigned char* ws = kp->ws;
    LAS unsigned* T = (LAS unsigned*)(lds + wave * 8448);
    {
        const int nitems = part == 1 ? I_DN : P0_NITEMS;
        for (int it = gw; it < nitems; it += NGW) {
            TTile cur = p0_item(kp, part, it); f32x4 v[16];
            if (cur.f8) { tt_load8(cur, v, lane); tt_store8(cur, v, T, lane); } else { tt_load(cur, v, lane); tt_store(cur, v, T, lane); }
        }
    }
    if (part == 1) return;
    {
        const float* x = kp->x; const float* meta = kp->meta; float* rs1 = (float*)(ws + WS_RS1);
        for (int g4 = gw; g4 * 4 < MROWS; g4 += NGW) {
            const int row0 = (NGW == 2048 && g4 < NTOK / 4) ? 2048 * ((g4 & 2047) >> 8) + 1024 * (g4 >> 11) + 4 * (g4 & 255) : g4 * 4;
            f32x4 v[4][4];
#pragma unroll
            for (int q = 0; q < 4; ++q) { const int row = row0 + q;
                const float* src = row < NTOK ? x + (size_t)row * D : (row < NTOK + NMETA ? meta + (size_t)(row - NTOK) * D : nullptr);
#pragma unroll
                for (int j = 0; j < 4; ++j) v[q][j] = src ? __builtin_nontemporal_load((const f32x4*)(src + j * 256 + lane * 4)) : (f32x4){0.f, 0.f, 0.f, 0.f}; }
#pragma unroll
            for (int q = 0; q < 4; ++q) { const int row = row0 + q; bf16_t* xb = (bf16_t*)(ws + WS_XB) + (size_t)row * D;
                float ss = 0.f;
#pragma unroll
                for (int j = 0; j < 4; ++j) { const f32x4 t = v[q][j]; ss += t.x * t.x + t.y * t.y + t.z * t.z + t.w * t.w;
                    u32x2 o; o.x = pk2(t.x, t.y); o.y = pk2(t.z, t.w); *(u32x2*)(xb + j * 256 + lane * 4) = o; }
                ss = wave_sum(ss);
                if (lane == 0) rs1[row] = rsqrtf(ss * (1.0f / D) + RMS_EPS); }
        }
    }
    for (int gid = gw * 64 + lane; gid < NGRP * 16 * 128; gid += NGW * 64) {
        float* abar = (float*)(ws + WS_ABAR); float* bbar = (float*)(ws + WS_BBAR); float* wr = (float*)(ws + WS_WR);
        if (gid < NGRP * NSTATE) {
            const int g = gid / NSTATE;
            const float are = kp->a_re[gid], aim = kp->a_im[gid], dt = expf(kp->log_dt[g]);
            const float mag = expf(are * dt), ang = aim * dt;
            const float br = mag * cosf(ang), bi = mag * sinf(ang);
            abar[gid * 2] = br; abar[gid * 2 + 1] = bi;
            const float den = are * are + aim * aim, nr = br - 1.0f, ni = bi;
            const float cr = (nr * are + ni * aim) / den, ci = (ni * are - nr * aim) / den;
            bf16_t* BB = (bf16_t*)(ws + WS_BB) + (size_t)g * 128 * 16; const int pch = gid % NSTATE;
            for (int c = 0; c < SSM_GC; ++c) { const float b_r = kp->b_re[gid * SSM_GC + c], b_i = kp->b_im[gid * SSM_GC + c];
                const float vr = cr * b_r - ci * b_i, vi = cr * b_i + ci * b_r;
                bbar[(gid * SSM_GC + c) * 2] = vr; bbar[(gid * SSM_GC + c) * 2 + 1] = vi;
                BB[pch * 16 + c] = f2bf(vr); BB[(64 + pch) * 16 + c] = f2bf(vi); }
        }
        if (gid < NGRP * 16 * 128) { const int comp = gid & 127, c = (gid >> 7) & 15, g = gid >> 11;
            const float v = comp < 64 ? kp->c_re[(g * SSM_GC + c) * NSTATE + comp] : -kp->c_im[(g * SSM_GC + c) * NSTATE + comp - 64];
            ((bf16_t*)(ws + WS_CC))[gid] = f2bf(v); }
        if (gid < D * NEXP) { const float v = kp->router_w[gid] * kp->ffn_g[gid / NEXP]; wr[gid] = v;
            const bf16_t hi = f2bf(v), lo = f2bf(v - bf2f(hi)); const int k = gid / NEXP, e = gid % NEXP;
            ((bf16_t*)(ws + WS_WRH))[e * D + k] = hi; ((bf16_t*)(ws + WS_WRL))[e * D + k] = lo; }
    }
}

DI void xcd_barrier_conv(const XcdBarrier& b, const P* kp, LAS unsigned char* lds, int conv0, int vcu, int wave, int lane) {
    asm volatile("s_waitcnt vmcnt(0)" ::: "memory");
    __syncthreads();
    if (wave != 0) { const int it = conv0 + 7 * vcu + wave - 1;
        if (it < I_DN) { LAS unsigned* T = (LAS unsigned*)(lds + wave * 8448); const TTile t = p0_item(kp, 1, it); f32x4 v[16]; tt_load8(t, v, lane); tt_store8(t, v, T, lane); } }
    if (threadIdx.x == 0) {
        unsigned* bar = b.bar;
        __builtin_amdgcn_s_waitcnt(0);
        unsigned nloc = b.st[0], nx = b.st[1];
        if (nloc == 0u) { xcd_barrier_complete(bar, b.x, nloc, nx); b.st[0] = nloc; b.st[1] = nx; }
        const unsigned old = xb_add(&bar[XB_XSUB(b.x)], 1u);
        const unsigned gen = old / nloc;
        if (old + 1u == (gen + 1u) * nloc) {
            __builtin_amdgcn_fence(__ATOMIC_RELEASE, "agent");
            asm volatile("s_waitcnt vmcnt(0)" ::: "memory");
            const unsigned og = xb_add(&bar[XB_TOP], 1u);
            const unsigned tg = og / nx;
            if (og + 1u == (tg + 1u) * nx) {
#pragma unroll
                for (int j = 0; j < 16; ++j) (void)xb_add(&bar[XB_XGEN(j)], 1u);
            } else XB_SPIN(xb_ld(&bar[XB_XGEN(b.x)]) == gen, bar);
            __builtin_amdgcn_fence(__ATOMIC_ACQUIRE, "agent");
            asm volatile("s_waitcnt vmcnt(0)" ::: "memory");
        } else {
            XB_SPIN(xb_ld(&bar[XB_XGEN(b.x)]) == gen, bar);
            __builtin_amdgcn_fence(__ATOMIC_ACQUIRE, "agent");
            asm volatile("s_waitcnt vmcnt(0)" ::: "memory");
        }
    }
    __syncthreads();
}

DI void p2_attn_simple(const P* kp, int bid, int G, int tid) {
    unsigned char* ws = kp->ws;
    const bf16_t* Q = (const bf16_t*)(ws + WS_Q); const bf16_t* KV = (const bf16_t*)(ws + WS_KV);
    const int i = tid & 127;
    for (int item = bid * 4 + (tid >> 7); item < BATCH * 32 * NH; item += G * 4) {
        const int n = item & 31, head = (item >> 5) & 15, b = item >> 9, kvh = head / KVREP;
        const int qrow = b * SEQ + n * 128 + i;
        float q[HD], o[HD];
#pragma unroll
        for (int d = 0; d < HD; d += 4) { load4_bf16(Q + (size_t)qrow * D + head * HD + d, q + d); o[d] = o[d + 1] = o[d + 2] = o[d + 3] = 0.f; }
        float m = kp->sinks[head] * LOG2E, l = 1.0f;
        for (int kk = 0; kk < NMETA + 256; ++kk) {
            int krow; bool vis;
            if (kk < NMETA) { krow = NTOK + kk; vis = true; }
            else { const int j = kk - NMETA; const int kpos = (n - 1) * 128 + j; krow = b * SEQ + kpos; vis = (kpos >= 0) && (j > i) && (j <= i + 128); }
            if (!vis) continue;
            const bf16_t* kp2 = KV + (size_t)krow * 256 + kvh * HD; const bf16_t* vp = kp2 + 128;
            float s = 0.f;
#pragma unroll
            for (int d = 0; d < HD; d += 4) { float kf[4]; load4_bf16(kp2 + d, kf); s += q[d] * kf[0] + q[d + 1] * kf[1] + q[d + 2] * kf[2] + q[d + 3] * kf[3]; }
            const float mn = fmaxf(m, s), al = exp2f(m - mn), pe = exp2f(s - mn);
            l = l * al + pe; m = mn;
#pragma unroll
            for (int d = 0; d < HD; d += 4) { float vf[4]; load4_bf16(vp + d, vf); o[d] = o[d] * al + pe * vf[0]; o[d + 1] = o[d + 1] * al + pe * vf[1]; o[d + 2] = o[d + 2] * al + pe * vf[2]; o[d + 3] = o[d + 3] * al + pe * vf[3]; }
        }
        const float inv = 1.0f / l;
        bf16_t* O = (bf16_t*)(ws + WS_ATT) + (size_t)qrow * D + head * HD;
#pragma unroll
        for (int d = 0; d < HD; d += 4) { float v[4] = {o[d] * inv, o[d + 1] * inv, o[d + 2] * inv, o[d + 3] * inv}; store4_bf16(O + d, v); }
    }
}

typedef short s16x4 __attribute__((ext_vector_type(4)));
typedef float f32x16 __attribute__((ext_vector_type(16)));
constexpr int ATT_V_OFF = 36864;
DI int crow16(int r, int h) { return (r & 3) + 8 * (r >> 2) + 4 * h; }
DI s16x4 lds_tr16(LAS unsigned char* p) { return __builtin_bit_cast(s16x4, __builtin_amdgcn_ds_read_tr16_b64_v4i16((LAS s16x4*)p)); }
DI void attn_unit(const P* kp, LAS unsigned char* lds, int b, int n, int kvh, int tid, int wave, int lane) {
    unsigned char* ws = kp->ws;
    const bf16_t* KV = (const bf16_t*)(ws + WS_KV); const bf16_t* Q = (const bf16_t*)(ws + WS_Q);
    __syncthreads();
    for (int c0 = wave * 64; c0 < 288 * 8 * 2; c0 += 512) {
        const int c = c0 + lane;
        const int which = c >= 2304 ? 1 : 0, cc = c - which * 2304, row = cc >> 3, dch = cc & 7;
        int src = NTOK + 16;
        if (row < 16) src = NTOK + row;
        else if (row >= 32) { const int kpos = (n - 1) * 128 + (row - 32); if (kpos >= 0) src = b * SEQ + kpos; }
        const int ch = which ? dch : (dch ^ (row & 7));
        __builtin_amdgcn_global_load_lds((const unsigned*)(KV + (size_t)src * 256 + which * 128 + kvh * HD + ch * 8), (LAS unsigned*)(lds + c0 * 16), 16, 0, 0);
    }
    asm volatile("s_waitcnt vmcnt(0)" ::: "memory");
    __syncthreads();
    const int l31 = lane & 31, h = lane >> 5, head = kvh * KVREP + wave;
    const float sink2 = kp->sinks[head] * LOG2E;
    const float NEG = -1.0e30f;
    const int grp = lane >> 4, qq = (lane & 15) >> 2, pp = lane & 3;
    const int vlane = (4 * (grp >> 1) + qq) * 128 + (16 * (grp & 1) + 4 * pp) * 2;
#pragma unroll 1
    for (int qi = 0; qi < 4; ++qi) {
        const int qrow = b * SEQ + n * 128 + qi * 32 + l31;
        bf16x8 qf[4];
#pragma unroll
        for (int ks = 0; ks < 4; ++ks) qf[ks] = __builtin_nontemporal_load((const bf16x8*)(Q + (size_t)qrow * D + head * HD + 16 * ks + 8 * h));
        f32x16 sc[6];
#pragma unroll
        for (int t = 0; t < 6; ++t) {
            const int row0 = (t == 0) ? 0 : 32 + 32 * (qi + t - 1);
            f32x16 acc = {0.f, 0.f, 0.f, 0.f, 0.f, 0.f, 0.f, 0.f, 0.f, 0.f, 0.f, 0.f, 0.f, 0.f, 0.f, 0.f};
            const int krow = row0 + l31;
#pragma unroll
            for (int ks = 0; ks < 4; ++ks) {
                const bf16x8 kf = *(const LAS bf16x8*)(lds + krow * 128 + (((2 * ks + h) ^ (krow & 7)) * 16));
                acc = __builtin_amdgcn_mfma_f32_32x32x16_bf16(kf, qf[ks], acc, 0, 0, 0);
            }
            if (t == 0) {
#pragma unroll
                for (int r = 8; r < 16; ++r) acc[r] = NEG;
            } else {
                if (t == 1) {
#pragma unroll
                    for (int r = 0; r < 16; ++r) acc[r] = (crow16(r, h) > l31) ? acc[r] : NEG;
                }
                if (t == 5) {
#pragma unroll
                    for (int r = 0; r < 16; ++r) acc[r] = (crow16(r, h) <= l31) ? acc[r] : NEG;
                }
                if (n == 0 && qi + t - 1 < 4) {
#pragma unroll
                    for (int r = 0; r < 16; ++r) acc[r] = NEG;
                }
            }
            sc[t] = acc;
        }
        float m = sink2;
#pragma unroll
        for (int t = 0; t < 6; ++t)
#pragma unroll
            for (int r = 0; r < 16; ++r) m = fmaxf(m, sc[t][r]);
        m = fmaxf(m, __shfl_xor(m, 32));
        float lsum = 0.f;
        f32x16 o0 = {0.f, 0.f, 0.f, 0.f, 0.f, 0.f, 0.f, 0.f, 0.f, 0.f, 0.f, 0.f, 0.f, 0.f, 0.f, 0.f}, o1 = o0;
#pragma unroll
        for (int t = 0; t < 6; ++t) {
            const int row0 = (t == 0) ? 0 : 32 + 32 * (qi + t - 1);
            float pe[16];
#pragma unroll
            for (int r = 0; r < 16; ++r) { pe[r] = __builtin_amdgcn_exp2f(sc[t][r] - m); lsum += pe[r]; }
#pragma unroll
            for (int s2 = 0; s2 < 2; ++s2) {
                u32x4 pw; pw.x = pk2(pe[8 * s2], pe[8 * s2 + 1]); pw.y = pk2(pe[8 * s2 + 2], pe[8 * s2 + 3]); pw.z = pk2(pe[8 * s2 + 4], pe[8 * s2 + 5]); pw.w = pk2(pe[8 * s2 + 6], pe[8 * s2 + 7]);
                const bf16x8 pb = __builtin_bit_cast(bf16x8, pw);
                LAS unsigned char* vb = lds + ATT_V_OFF + (row0 + 16 * s2) * 128 + vlane;
                const s16x4 a0l = lds_tr16(vb), a0h = lds_tr16(vb + 8 * 128), a1l = lds_tr16(vb + 64), a1h = lds_tr16(vb + 8 * 128 + 64);
                const bf16x8 va0 = __builtin_shufflevector(a0l, a0h, 0, 1, 2, 3, 4, 5, 6, 7), va1 = __builtin_shufflevector(a1l, a1h, 0, 1, 2, 3, 4, 5, 6, 7);
                o0 = __builtin_amdgcn_mfma_f32_32x32x16_bf16(va0, pb, o0, 0, 0, 0);
                o1 = __builtin_amdgcn_mfma_f32_32x32x16_bf16(va1, pb, o1, 0, 0, 0);
            }
        }
        lsum += __shfl_xor(lsum, 32);
        lsum += __builtin_amdgcn_exp2f(sink2 - m);
        const float inv = __builtin_amdgcn_rcpf(lsum);
        bf16_t* O = (bf16_t*)(ws + WS_ATT) + (size_t)qrow * D + head * HD;
#pragma unroll
        for (int g4 = 0; g4 < 4; ++g4) {
            float v0[4] = {o0[4 * g4] * inv, o0[4 * g4 + 1] * inv, o0[4 * g4 + 2] * inv, o0[4 * g4 + 3] * inv};
            float v1[4] = {o1[4 * g4] * inv, o1[4 * g4 + 1] * inv, o1[4 * g4 + 2] * inv, o1[4 * g4 + 3] * inv};
            store4_bf16(O + 8 * g4 + 4 * h, v0); store4_bf16(O + 32 + 8 * g4 + 4 * h, v1);
        }
    }
}

DI void p3_ssm_simple(const P* kp, LAS unsigned char* lds, int g, int b, int wave, int lane) {
    unsigned char* ws = kp->ws;
    LAS float* sre = (LAS float*)(lds + wave * 512); LAS float* sim = sre + 64;
    const float* abar = (const float*)(ws + WS_ABAR); const float* bbar = (const float*)(ws + WS_BBAR);
    const bf16_t* U = (const bf16_t*)(ws + WS_U); bf16_t* YG = (bf16_t*)(ws + WS_YG);
    const float ar = abar[(g * NSTATE + lane) * 2], ai = abar[(g * NSTATE + lane) * 2 + 1];
    float bbr[16], bbi[16];
#pragma unroll
    for (int c = 0; c < 16; ++c) { bbr[c] = bbar[((g * NSTATE + lane) * 16 + c) * 2]; bbi[c] = bbar[((g * NSTATE + lane) * 16 + c) * 2 + 1]; }
    const int oc = lane & 15, oq = lane >> 4;
    float cr[16], ci[16];
#pragma unroll
    for (int i2 = 0; i2 < 16; ++i2) { cr[i2] = kp->c_re[(g * SSM_GC + oc) * NSTATE + oq * 16 + i2]; ci[i2] = kp->c_im[(g * SSM_GC + oc) * NSTATE + oq * 16 + i2]; }
    const float dsk = kp->dskip[g * SSM_GC + oc];
    float s_r = 0.f, s_i = 0.f;
    u32x4 nx0 = *(const u32x4*)(U + (size_t)NTOK * SSM_W + g * SSM_GC), nx1 = *(const u32x4*)(U + (size_t)NTOK * SSM_W + g * SSM_GC + 8);
    for (int t = 0; t < NMETA + SEQ; ++t) {
        const int row = t < NMETA ? NTOK + t : b * SEQ + (t - NMETA);
        const u32x4 c0 = nx0, c1 = nx1;
        { const int t2 = t + 1 < NMETA + SEQ ? t + 1 : t; const int row2 = t2 < NMETA ? NTOK + t2 : b * SEQ + (t2 - NMETA);
          nx0 = *(const u32x4*)(U + (size_t)row2 * SSM_W + g * SSM_GC); nx1 = *(const u32x4*)(U + (size_t)row2 * SSM_W + g * SSM_GC + 8); }
        float u[16];
        u[0] = __uint_as_float(c0.x << 16); u[1] = __uint_as_float(c0.x & 0xffff0000u); u[2] = __uint_as_float(c0.y << 16); u[3] = __uint_as_float(c0.y & 0xffff0000u);
        u[4] = __uint_as_float(c0.z << 16); u[5] = __uint_as_float(c0.z & 0xffff0000u); u[6] = __uint_as_float(c0.w << 16); u[7] = __uint_as_float(c0.w & 0xffff0000u);
        u[8] = __uint_as_float(c1.x << 16); u[9] = __uint_as_float(c1.x & 0xffff0000u); u[10] = __uint_as_float(c1.y << 16); u[11] = __uint_as_float(c1.y & 0xffff0000u);
        u[12] = __uint_as_float(c1.z << 16); u[13] = __uint_as_float(c1.z & 0xffff0000u); u[14] = __uint_as_float(c1.w << 16); u[15] = __uint_as_float(c1.w & 0xffff0000u);
        float br = 0.f, bi = 0.f;
#pragma unroll
        for (int c = 0; c < 16; ++c) { br += bbr[c] * u[c]; bi += bbi[c] * u[c]; }
        const float nr = ar * s_r - ai * s_i + br, ni = ar * s_i + ai * s_r + bi;
        s_r = nr; s_i = ni;
        if (t >= NMETA) {
            asm volatile("s_waitcnt lgkmcnt(0)" ::: "memory");
            sre[lane] = s_r; sim[lane] = s_i;
            asm volatile("s_waitcnt lgkmcnt(0)" ::: "memory");
            float y = 0.f;
#pragma unroll
            for (int i2 = 0; i2 < 16; ++i2) y += cr[i2] * sre[oq * 16 + i2] - ci[i2] * sim[oq * 16 + i2];
            y += __shfl_xor(y, 16); y += __shfl_xor(y, 32);
            if (lane < 16) { const float yv = y + dsk * u[oc]; YG[(size_t)row * YG_P + g * SSM_GC + oc] = f2bf(gelu_tanh(yv)); }
        }
    }
}

constexpr int SSM_LDS_WAVE = 17920, SSM_BU_P = 72, SSM_S_P = 272, SSM_S_OFF = 9216;
DI float fma_s(float a, float b, float c) { float r; asm("v_fma_f32 %0, %1, %2, %3" : "=v"(r) : "v"(a), "v"(b), "v"(c)); return r; }
DI float ld_agent(const float* p) { return __uint_as_float(__hip_atomic_load((const unsigned*)p, __ATOMIC_RELAXED, __HIP_MEMORY_SCOPE_AGENT)); }
template <bool PASS_C> DI unsigned ssm_span(const P* kp, LAS unsigned char* lw, LAS float* Ew, int b, int g, int w, int lane) {
    unsigned char* ws = kp->ws;
    unsigned hsh = 0u;
    const int l31 = lane & 31, h = lane >> 5, l15 = lane & 15, kg = lane >> 4, odd = lane & 1;
    const bf16_t* U = (const bf16_t*)(ws + WS_U);
    bf16x8 bb[4];
#pragma unroll
    for (int nt = 0; nt < 4; ++nt) bb[nt] = *(const bf16x8*)((const bf16_t*)(ws + WS_BB) + ((size_t)g * 128 + 32 * nt + l31) * 16 + 8 * h);
    bf16x8 cc[4];
    if (PASS_C) {
#pragma unroll
        for (int ks = 0; ks < 4; ++ks) cc[ks] = *(const bf16x8*)((const bf16_t*)(ws + WS_CC) + ((size_t)g * 16 + l15) * 128 + 32 * ks + 8 * kg);
    }
    const float ar = ((const float*)(ws + WS_ABAR))[(g * NSTATE + lane) * 2], ai = ((const float*)(ws + WS_ABAR))[(g * NSTATE + lane) * 2 + 1];
    const float nai = -ai;
    float s_r = 0.f, s_i = 0.f;
    if (PASS_C && w > 0) {
        float pr = ar, pi = ai;
#pragma unroll
        for (int q = 0; q < 9; ++q) { const float nr = pr * pr - pi * pi, ni = 2.f * pr * pi; pr = nr; pi = ni; }
        s_r = Ew[lane]; s_i = Ew[64 + lane];
        for (int j = 1; j < w; ++j) { const float er = Ew[j * 128 + lane], ei = Ew[j * 128 + 64 + lane];
            const float nr = pr * s_r - pi * s_i + er, ni = pr * s_i + pi * s_r + ei; s_r = nr; s_i = ni; }
    }
    const int r_first = (w == 0) ? -1 : 0;
    for (int rd = r_first; rd < 16; ++rd) {
        bf16x8 a;
        if (rd < 0) { a = (bf16x8){0, 0, 0, 0, 0, 0, 0, 0}; if (l31 >= 16) a = *(const bf16x8*)(U + (size_t)(NTOK + l31 - 16) * SSM_W + g * SSM_GC + 8 * h); }
        else a = *(const bf16x8*)(U + (size_t)(b * SEQ + w * 512 + rd * 32 + l31) * SSM_W + g * SSM_GC + 8 * h);
        const f32x16 z16 = {0.f, 0.f, 0.f, 0.f, 0.f, 0.f, 0.f, 0.f, 0.f, 0.f, 0.f, 0.f, 0.f, 0.f, 0.f, 0.f};
#pragma unroll
        for (int nt = 0; nt < 4; ++nt) {
            const f32x16 acc = __builtin_amdgcn_mfma_f32_32x32x16_bf16(a, bb[nt], z16, 0, 0, 0);
#pragma unroll
            for (int q = 0; q < 4; ++q) { u32x2 wv; wv.x = pk2(acc[4 * q], acc[4 * q + 1]); wv.y = pk2(acc[4 * q + 2], acc[4 * q + 3]);
                *(LAS u32x2*)(lw + (32 * nt + l31) * SSM_BU_P + (8 * q + 4 * h) * 2) = wv; }
        }
        asm volatile("s_waitcnt lgkmcnt(0)" ::: "memory");
#pragma unroll
        for (int tb = 0; tb < 8; ++tb) {
            const u32x2 re4 = *(const LAS u32x2*)(lw + lane * SSM_BU_P + tb * 8), im4 = *(const LAS u32x2*)(lw + (64 + lane) * SSM_BU_P + tb * 8);
            const float br[4] = {__uint_as_float(re4.x << 16), __uint_as_float(re4.x & 0xffff0000u), __uint_as_float(re4.y << 16), __uint_as_float(re4.y & 0xffff0000u)};
            const float bi[4] = {__uint_as_float(im4.x << 16), __uint_as_float(im4.x & 0xffff0000u), __uint_as_float(im4.y << 16), __uint_as_float(im4.y & 0xffff0000u)};
#pragma unroll
            for (int q2 = 0; q2 < 2; ++q2) {
                unsigned ri[2];
#pragma unroll
                for (int e = 0; e < 2; ++e) { const int q = 2 * q2 + e;
                    const float nr = fma_s(ar, s_r, fma_s(nai, s_i, br[q])), ni = fma_s(ar, s_i, fma_s(ai, s_r, bi[q])); s_r = nr; s_i = ni;
                    ri[e] = pk2(s_r, s_i); }
                if (PASS_C && rd >= 0) {
                    const int t = tb * 4 + 2 * q2;
                    const unsigned recv = (unsigned)__shfl_xor((int)(odd ? ri[0] : ri[1]), 1);
                    const unsigned dr = odd ? ((recv & 0xffffu) | (ri[1] << 16)) : ((ri[0] & 0xffffu) | (recv << 16));
                    const unsigned di = odd ? ((recv >> 16) | (ri[1] & 0xffff0000u)) : ((ri[0] >> 16) | (recv & 0xffff0000u));
                    const int off = SSM_S_OFF + (t + odd) * SSM_S_P + (lane & ~1) * 2;
                    *(LAS unsigned*)(lw + off) = dr; *(LAS unsigned*)(lw + off + 128) = di;
                }
            }
        }
        if (PASS_C && rd >= 0) {
            asm volatile("s_waitcnt lgkmcnt(0)" ::: "memory");
#pragma unroll
            for (int ntile = 0; ntile < 2; ++ntile) {
                f32x4 y = {0.f, 0.f, 0.f, 0.f};
#pragma unroll
                for (int ks = 0; ks < 4; ++ks) { const bf16x8 sb = *(const LAS bf16x8*)(lw + SSM_S_OFF + (16 * ntile + l15) * SSM_S_P + (32 * ks + 8 * kg) * 2);
                    y = __builtin_amdgcn_mfma_f32_16x16x32_bf16(cc[ks], sb, y, 0, 0, 0); }
                const int row = b * SEQ + w * 512 + rd * 32 + 16 * ntile + l15, ch = g * SSM_GC + 4 * kg;
                float u4[4]; load4_bf16(U + (size_t)row * SSM_W + ch, u4);
                const f32x4 dk = *(const f32x4*)(kp->dskip + ch);
                float o[4] = {gelu_tanh(y.x + dk.x * u4[0]), gelu_tanh(y.y + dk.y * u4[1]), gelu_tanh(y.z + dk.z * u4[2]), gelu_tanh(y.w + dk.w * u4[3])};
                store4_bf16((bf16_t*)(ws + WS_YG) + (size_t)row * YG_P + ch, o);
                hsh = (hsh << 5 | hsh >> 27) ^ pk2(o[0], o[1]); hsh = (hsh << 5 | hsh >> 27) ^ pk2(o[2], o[3]);
            }
        }
        asm volatile("s_waitcnt lgkmcnt(0)" ::: "memory");
    }
    if (!PASS_C && w < 7) { Ew[w * 128 + lane] = s_r; Ew[w * 128 + 64 + lane] = s_i; }
    return hsh;
}

DI float mul_s(float a, float b) { float r; asm("v_mul_f32 %0, %1, %2" : "=v"(r) : "v"(a), "v"(b)); return r; }
DI void cmul(float& xr, float& xi, float ar, float ai) { const float nr = fma_s(xr, ar, -mul_s(xi, ai)), ni = fma_s(xr, ai, mul_s(xi, ar)); xr = nr; xi = ni; }
DI void ssm_end_state(const P* kp, int g, int row0, int nrounds, bool meta, int lane, float (&e)[4]) {
    unsigned char* ws = kp->ws;
    const int l31 = lane & 31, h = lane >> 5;
    const bf16_t* U = (const bf16_t*)(ws + WS_U);
    bf16x8 bb[4];
#pragma unroll
    for (int nt = 0; nt < 4; ++nt) bb[nt] = *(const bf16x8*)((const bf16_t*)(ws + WS_BB) + ((size_t)g * 128 + 32 * nt + l31) * 16 + 8 * h);
    const float* ab = (const float*)(ws + WS_ABAR) + (size_t)g * NSTATE * 2;
    float a1r[2], a1i[2], a4r[2], a4i[2], a32r[2], a32i[2];
#pragma unroll
    for (int c = 0; c < 2; ++c) { a1r[c] = ab[(32 * c + l31) * 2]; a1i[c] = ab[(32 * c + l31) * 2 + 1];
        float pr = a1r[c], pi = a1i[c]; cmul(pr, pi, pr, pi); cmul(pr, pi, pr, pi); a4r[c] = pr; a4i[c] = pi;
        cmul(pr, pi, pr, pi); cmul(pr, pi, pr, pi); cmul(pr, pi, pr, pi); a32r[c] = pr; a32i[c] = pi; }
    float Er[2] = {0.f, 0.f}, Ei[2] = {0.f, 0.f};
    const bf16_t* ubase = U + (size_t)g * SSM_GC + 8 * h;
    bf16x8 an;
    if (meta) { an = (bf16x8){0, 0, 0, 0, 0, 0, 0, 0}; if (l31 >= 16) an = *(const bf16x8*)(ubase + (size_t)(NTOK + l31 - 16) * SSM_W); }
    else an = *(const bf16x8*)(ubase + (size_t)(row0 + l31) * SSM_W);
    for (int rd = meta ? -1 : 0; rd < nrounds; ++rd) {
        const bf16x8 a = an;
        { const int rn = rd + 1 < nrounds ? rd + 1 : rd; an = *(const bf16x8*)(ubase + (size_t)(row0 + rn * 32 + l31) * SSM_W); }
        const f32x16 z16 = {0.f, 0.f, 0.f, 0.f, 0.f, 0.f, 0.f, 0.f, 0.f, 0.f, 0.f, 0.f, 0.f, 0.f, 0.f, 0.f};
#pragma unroll
        for (int c = 0; c < 2; ++c) {
            const f32x16 bre = __builtin_amdgcn_mfma_f32_32x32x16_bf16(a, bb[c], z16, 0, 0, 0);
            const f32x16 bim = __builtin_amdgcn_mfma_f32_32x32x16_bf16(a, bb[2 + c], z16, 0, 0, 0);
            float er = 0.f, ei = 0.f;
#pragma unroll
            for (int q = 0; q < 4; ++q) {
                if (q > 0) cmul(er, ei, a4r[c], a4i[c]);
#pragma unroll
                for (int i = 0; i < 4; ++i) { cmul(er, ei, a1r[c], a1i[c]); er += bre[4 * q + i]; ei += bim[4 * q + i]; }
            }
            const float pr = __shfl_xor(er, 32), pi = __shfl_xor(ei, 32);
            float lo_r = h ? pr : er, lo_i = h ? pi : ei; const float hi_r = h ? er : pr, hi_i = h ? ei : pi;
            cmul(lo_r, lo_i, a4r[c], a4i[c]);
            cmul(Er[c], Ei[c], a32r[c], a32i[c]); Er[c] += lo_r + hi_r; Ei[c] += lo_i + hi_i;
        }
    }
    e[0] = Er[0]; e[1] = Er[1]; e[2] = Ei[0]; e[3] = Ei[1];
}
DI void ssm_span_c(const P* kp, LAS unsigned char* lw, int g, int row0, float s_r, float s_i, int lane) {
    unsigned char* ws = kp->ws;
    const int l31 = lane & 31, h = lane >> 5, l15 = lane & 15, kg = lane >> 4, odd = lane & 1;
    const bf16_t* U = (const bf16_t*)(ws + WS_U);
    bf16x8 bb[4];
#pragma unroll
    for (int nt = 0; nt < 4; ++nt) bb[nt] = *(const bf16x8*)((const bf16_t*)(ws + WS_BB) + ((size_t)g * 128 + 32 * nt + l31) * 16 + 8 * h);
    bf16x8 cc[4];
#pragma unroll
    for (int ks = 0; ks < 4; ++ks) cc[ks] = *(const bf16x8*)((const bf16_t*)(ws + WS_CC) + ((size_t)g * 16 + l15) * 128 + 32 * ks + 8 * kg);
    const float ar = ((const float*)(ws + WS_ABAR))[(g * NSTATE + lane) * 2], ai = ((const float*)(ws + WS_ABAR))[(g * NSTATE + lane) * 2 + 1], nai = -ai;
    const int ch = g * SSM_GC + 4 * kg;
    const f32x4 dk = *(const f32x4*)(kp->dskip + ch);
    bf16x8 an = *(const bf16x8*)(U + (size_t)(row0 + l31) * SSM_W + g * SSM_GC + 8 * h);
    for (int rd = 0; rd < 8; ++rd) {
        const bf16x8 a = an;
        { const int rn = rd + 1 < 8 ? rd + 1 : rd; an = *(const bf16x8*)(U + (size_t)(row0 + rn * 32 + l31) * SSM_W + g * SSM_GC + 8 * h); }
        const u32x2 uw0 = *(const u32x2*)(U + (size_t)(row0 + rd * 32 + l15) * SSM_W + ch), uw1 = *(const u32x2*)(U + (size_t)(row0 + rd * 32 + 16 + l15) * SSM_W + ch);
        const f32x16 z16 = {0.f, 0.f, 0.f, 0.f, 0.f, 0.f, 0.f, 0.f, 0.f, 0.f, 0.f, 0.f, 0.f, 0.f, 0.f, 0.f};
#pragma unroll
        for (int nt = 0; nt < 4; ++nt) {
            const f32x16 acc = __builtin_amdgcn_mfma_f32_32x32x16_bf16(a, bb[nt], z16, 0, 0, 0);
#pragma unroll
            for (int q = 0; q < 4; ++q) { u32x2 wv; wv.x = pk2(acc[4 * q], acc[4 * q + 1]); wv.y = pk2(acc[4 * q + 2], acc[4 * q + 3]);
                *(LAS u32x2*)(lw + (32 * nt + l31) * SSM_BU_P + (8 * q + 4 * h) * 2) = wv; }
        }
        asm volatile("s_waitcnt lgkmcnt(0)" ::: "memory");
#pragma unroll
        for (int tb = 0; tb < 8; ++tb) {
            const u32x2 re4 = *(const LAS u32x2*)(lw + lane * SSM_BU_P + tb * 8), im4 = *(const LAS u32x2*)(lw + (64 + lane) * SSM_BU_P + tb * 8);
            const float br[4] = {__uint_as_float(re4.x << 16), __uint_as_float(re4.x & 0xffff0000u), __uint_as_float(re4.y << 16), __uint_as_float(re4.y & 0xffff0000u)};
            const float bi[4] = {__uint_as_float(im4.x << 16), __uint_as_float(im4.x & 0xffff0000u), __uint_as_float(im4.y << 16), __uint_as_float(im4.y & 0xffff0000u)};
#pragma unroll
            for (int q2 = 0; q2 < 2; ++q2) {
                unsigned ri[2];
#pragma unroll
                for (int e = 0; e < 2; ++e) { const int q = 2 * q2 + e;
                    const float nr = fma_s(ar, s_r, fma_s(nai, s_i, br[q])), ni = fma_s(ar, s_i, fma_s(ai, s_r, bi[q])); s_r = nr; s_i = ni;
                    ri[e] = pk2(s_r, s_i); }
                const int t = tb * 4 + 2 * q2;
                const unsigned recv = (unsigned)__shfl_xor((int)(odd ? ri[0] : ri[1]), 1);
                const unsigned dr = odd ? ((recv & 0xffffu) | (ri[1] << 16)) : ((ri[0] & 0xffffu) | (recv << 16));
                const unsigned di = odd ? ((recv >> 16) | (ri[1] & 0xffff0000u)) : ((ri[0] >> 16) | (recv & 0xffff0000u));
                const int off = SSM_S_OFF + (t + odd) * SSM_S_P + (lane & ~1) * 2;
                *(LAS unsigned*)(lw + off) = dr; *(LAS unsigned*)(lw + off + 128) = di;
            }
        }
        asm volatile("s_waitcnt lgkmcnt(0)" ::: "memory");
#pragma unroll
        for (int ntile = 0; ntile < 2; ++ntile) {
            f32x4 y = {0.f, 0.f, 0.f, 0.f};
#pragma unroll
            for (int ks = 0; ks < 4; ++ks) { const bf16x8 sb = *(const LAS bf16x8*)(lw + SSM_S_OFF + (16 * ntile + l15) * SSM_S_P + (32 * ks + 8 * kg) * 2);
                y = __builtin_amdgcn_mfma_f32_16x16x32_bf16(cc[ks], sb, y, 0, 0, 0); }
            const int row = row0 + rd * 32 + 16 * ntile + l15;
            const u32x2 uw = ntile ? uw1 : uw0;
            const float u4[4] = {__uint_as_float(uw.x << 16), __uint_as_float(uw.x & 0xffff0000u), __uint_as_float(uw.y << 16), __uint_as_float(uw.y & 0xffff0000u)};
            float o[4] = {gelu_tanh(y.x + dk.x * u4[0]), gelu_tanh(y.y + dk.y * u4[1]), gelu_tanh(y.z + dk.z * u4[2]), gelu_tanh(y.w + dk.w * u4[3])};
            store4_bf16((bf16_t*)(ws + WS_YG) + (size_t)row * YG_P + ch, o);
        }
        asm volatile("s_waitcnt lgkmcnt(0)" ::: "memory");
    }
}
DI void ssm_block(const P* kp, LAS unsigned char* lds, int b, int g, int half, int wave, int lane) {
    LAS float* Ew = (LAS float*)(lds + 8 * SSM_LDS_WAVE);
    const int l31 = lane & 31, h = lane >> 5;
    float e[4];
    ssm_end_state(kp, g, b * SEQ + wave * 256, 8, wave == 0, lane, e);
    if (h == 0) { Ew[wave * 128 + l31] = e[0]; Ew[wave * 128 + 32 + l31] = e[1]; Ew[wave * 128 + 64 + l31] = e[2]; Ew[wave * 128 + 96 + l31] = e[3]; }
    if (half) { ssm_end_state(kp, g, b * SEQ + 2048 + wave * 256, 8, false, lane, e);
        if (h == 0) { Ew[(8 + wave) * 128 + l31] = e[0]; Ew[(8 + wave) * 128 + 32 + l31] = e[1]; Ew[(8 + wave) * 128 + 64 + l31] = e[2]; Ew[(8 + wave) * 128 + 96 + l31] = e[3]; } }
    asm volatile("s_waitcnt lgkmcnt(0)" ::: "memory");
    __syncthreads();
    const float ar = ((const float*)(kp->ws + WS_ABAR))[(g * NSTATE + lane) * 2], ai = ((const float*)(kp->ws + WS_ABAR))[(g * NSTATE + lane) * 2 + 1];
    float pr = ar, pi = ai;
#pragma unroll
    for (int q = 0; q < 8; ++q) cmul(pr, pi, pr, pi);
    float s_r = 0.f, s_i = 0.f;
    const int nprev = half * 8 + wave;
    for (int j = 0; j < nprev; ++j) { cmul(s_r, s_i, pr, pi); s_r += Ew[j * 128 + lane]; s_i += Ew[j * 128 + 64 + lane]; }
    ssm_span_c(kp, lds + wave * SSM_LDS_WAVE, g, b * SEQ + half * 2048 + wave * 256, s_r, s_i, lane);
}


DI void p6_route(const P* kp, LAS unsigned char* lds, int bid, int G, int tid, int wave, int lane) {
    unsigned char* ws = kp->ws;
    LAS float* part = (LAS float*)lds; LAS float* ssp = part + 8 * 64 * 33; LAS float* lg = ssp + 8 * 64; LAS unsigned* hist = (LAS unsigned*)(lg + 64 * 33); LAS unsigned* base = hist + 32;
    const float* wr = (const float*)(ws + WS_WR);
    const int l31 = lane & 31, kh = lane >> 5;
    for (int t0 = bid * 64; t0 < NTOK; t0 += G * 64) {
        __syncthreads();
        if (tid < 32) hist[tid] = 0u;
        f32x16 acc0 = {0.f, 0.f, 0.f, 0.f, 0.f, 0.f, 0.f, 0.f, 0.f, 0.f, 0.f, 0.f, 0.f, 0.f, 0.f, 0.f}, acc1 = acc0;
        float ss0 = 0.f, ss1 = 0.f;
        const bf16_t* h0 = (const bf16_t*)(ws + WS_H1) + (size_t)(t0 + l31) * D + wave * 128 + 8 * kh;
        const bf16_t* h1p = h0 + (size_t)32 * D;
        const bf16_t* wh = (const bf16_t*)(ws + WS_WRH) + (size_t)l31 * D + wave * 128 + 8 * kh; const bf16_t* wl = (const bf16_t*)(ws + WS_WRL) + (size_t)l31 * D + wave * 128 + 8 * kh;
#pragma unroll
        for (int st = 0; st < 8; ++st) {
            const bf16x8 x0 = *(const bf16x8*)(h0 + 16 * st), x1 = *(const bf16x8*)(h1p + 16 * st), ah = *(const bf16x8*)(wh + 16 * st), al = *(const bf16x8*)(wl + 16 * st);
#pragma unroll
            for (int j = 0; j < 8; ++j) { const float f0 = bf2f((bf16_t)x0[j]), f1 = bf2f((bf16_t)x1[j]); ss0 += f0 * f0; ss1 += f1 * f1; }
            acc0 = __builtin_amdgcn_mfma_f32_32x32x16_bf16(ah, x0, acc0, 0, 0, 0); acc1 = __builtin_amdgcn_mfma_f32_32x32x16_bf16(ah, x1, acc1, 0, 0, 0);
            acc0 = __builtin_amdgcn_mfma_f32_32x32x16_bf16(al, x0, acc0, 0, 0, 0); acc1 = __builtin_amdgcn_mfma_f32_32x32x16_bf16(al, x1, acc1, 0, 0, 0);
        }
#pragma unroll
        for (int r = 0; r < 16; ++r) { part[(wave * 64 + l31) * 33 + crow16(r, kh)] = acc0[r]; part[(wave * 64 + 32 + l31) * 33 + crow16(r, kh)] = acc1[r]; }
        ss0 += __shfl_xor(ss0, 32); ss1 += __shfl_xor(ss1, 32);
        if (kh == 0) { ssp[wave * 64 + l31] = ss0; ssp[wave * 64 + 32 + l31] = ss1; }
        __syncthreads();
        float r2;
        {
            const int tk = tid & 63, eg = tid >> 6;
            float ssum = 0.f;
#pragma unroll
            for (int w = 0; w < 8; ++w) ssum += ssp[w * 64 + tk];
            r2 = rsqrtf(ssum * (1.0f / D) + RMS_EPS);
#pragma unroll
            for (int e = 4 * eg; e < 4 * eg + 4; ++e) { float a = 0.f;
#pragma unroll
                for (int w = 0; w < 8; ++w) a += part[(w * 64 + tk) * 33 + e];
                lg[tk * 33 + e] = a * r2 + kp->router_b[e]; }
            if (eg == 0) ((float*)(ws + WS_RS2))[t0 + tk] = r2;
        }
        __syncthreads();
        int id[4] = {0, 0, 0, 0}; float gt[4] = {0.f, 0.f, 0.f, 0.f}; unsigned rk[4] = {0u, 0u, 0u, 0u};
        if (tid < 64) {
            float v[4]; unsigned used = 0u;
#pragma unroll
            for (int k = 0; k < TOPK; ++k) { float best = -3.0e38f; int bi = 0;
#pragma unroll
                for (int j = 0; j < NEXP; ++j) { const float x = lg[tid * 33 + j]; const bool take = !((used >> j) & 1u) && x > best; best = take ? x : best; bi = take ? j : bi; }
                used |= 1u << bi; v[k] = best; id[k] = bi; }
            float den = 0.f, ex[4];
#pragma unroll
            for (int k = 0; k < TOPK; ++k) { ex[k] = __expf(v[k] - v[0]); den += ex[k]; }
            const float rden = 1.0f / den;
#pragma unroll
            for (int k = 0; k < TOPK; ++k) { gt[k] = ex[k] * rden; rk[k] = __hip_atomic_fetch_add(&hist[id[k]], 1u, __ATOMIC_RELAXED, __HIP_MEMORY_SCOPE_WORKGROUP); }
        }
        __syncthreads();
        if (tid < 32) base[tid] = atomicAdd((unsigned*)(ws + WS_CTL) + CW_GCOUNT + tid, hist[tid]);
        __syncthreads();
        if (tid < 64) {
            const int tok = t0 + tid;
#pragma unroll
            for (int k = 0; k < TOPK; ++k) { const unsigned pos = base[id[k]] + rk[k];
                ((int*)(ws + WS_LTOK))[(size_t)id[k] * NTOK + pos] = tok;
                ((float*)(ws + WS_LGATE))[(size_t)id[k] * NTOK + pos] = gt[k];
                ((float*)(ws + WS_LRS))[(size_t)id[k] * NTOK + pos] = r2;
                ((int*)(ws + WS_TSLOT))[tok * 4 + k] = (id[k] << 16) | (int)pos; }
        }
    }
}

DI void p9_combine(const P* kp, int gw, int NGW, int lane) {
    unsigned char* ws = kp->ws;
    const unsigned* gcount = (const unsigned*)(ws + WS_CTL) + CW_GCOUNT;
    int mystart;
    { const int c = (int)__hip_atomic_load(gcount + (lane & 31), __ATOMIC_RELAXED, __HIP_MEMORY_SCOPE_AGENT); const int n = ((c + 255) >> 8) * 256; int incl = n;
#pragma unroll
      for (int d = 1; d < 32; d <<= 1) { const int v = __shfl_up(incl, d, 32); if ((lane & 31) >= d) incl += v; }
      mystart = incl - n; }
    const unsigned char* YS8 = ws + WS_YS; const float* fg = kp->final_g; float* out = kp->out;
    for (int tok = gw; tok < NTOK; tok += NGW) {
        const bf16_t* h1 = (const bf16_t*)(ws + WS_H1) + (size_t)tok * D;
        int slot[4];
#pragma unroll
        for (int k = 0; k < 4; ++k) { const int w = ((const int*)(ws + WS_TSLOT))[tok * 4 + k]; slot[k] = __shfl(mystart, w >> 16) + (w & 0xffff); }
        float v[16]; float ss = 0.f;
#pragma unroll
        for (int j = 0; j < 4; ++j) {
            const int c = j * 256 + lane * 4; const u32x2 h = *(const u32x2*)(h1 + c);
            float a[4] = {__uint_as_float(h.x << 16), __uint_as_float(h.x & 0xffff0000u), __uint_as_float(h.y << 16), __uint_as_float(h.y & 0xffff0000u)};
            float ya[4] = {0.f, 0.f, 0.f, 0.f};
#pragma unroll
            for (int k = 0; k < 4; ++k) { const int w = *(const int*)(YS8 + (size_t)slot[k] * D + c);
                ya[0] += __builtin_amdgcn_cvt_f32_fp8(w, 0); ya[1] += __builtin_amdgcn_cvt_f32_fp8(w, 1); ya[2] += __builtin_amdgcn_cvt_f32_fp8(w, 2); ya[3] += __builtin_amdgcn_cvt_f32_fp8(w, 3); }
            a[0] += ya[0] * (1.0f / YS_SCALE); a[1] += ya[1] * (1.0f / YS_SCALE); a[2] += ya[2] * (1.0f / YS_SCALE); a[3] += ya[3] * (1.0f / YS_SCALE);
#pragma unroll
            for (int q = 0; q < 4; ++q) { v[j * 4 + q] = a[q]; ss += a[q] * a[q]; }
        }
        ss = wave_sum(ss);
        const float r = rsqrtf(ss * (1.0f / D) + RMS_EPS);
#pragma unroll
        for (int j = 0; j < 4; ++j) { const int c = j * 256 + lane * 4; const f32x4 g = *(const f32x4*)(fg + c);
            *(f32x4*)(out + (size_t)tok * D + c) = (f32x4){v[j * 4] * r * g.x, v[j * 4 + 1] * r * g.y, v[j * 4 + 2] * r * g.z, v[j * 4 + 3] * r * g.w}; }
    }
}

constexpr int MEGA_LDS = 163840;
constexpr int LDS_MISC = 163328;
static_assert(8 * SSM_LDS_WAVE + 16 * 512 <= LDS_MISC, "SSM LDS map");
__global__ void __launch_bounds__(512, 2) mega(P p_unused, int ph_lo, int ph_hi) {
    extern __shared__ __attribute__((aligned(16))) unsigned char lds_raw[];
    LAS unsigned char* lds = (LAS unsigned char*)lds_raw;
    const P* kp = (const P*)__builtin_amdgcn_kernarg_segment_ptr();
    const int tid = threadIdx.x, lane = tid & 63, wave = __builtin_amdgcn_readfirstlane(tid >> 6);
    const int G = gridDim.x, bid = blockIdx.x;
    const int vcu = (G % 8 == 0) ? (bid % 8) * (G / 8) + bid / 8 : bid;
    const int gw = vcu * 8 + wave, NGW = G * 8;
    volatile LAS unsigned* MISC = (volatile LAS unsigned*)(lds + LDS_MISC);
    { int tz = tid; asm volatile("" : "+v"(tz));
      for (int i = tz; i < MEGA_LDS / 4; i += 512) ((LAS unsigned*)lds)[i] = 0u; }
    __syncthreads();
    const bool fused = (ph_hi - ph_lo) > 1;
    XcdBarrier bar; bar.bar = (unsigned*)(kp->ws + WS_CTL) + CW_BAR; bar.x = 0; bar.st = MISC + 8;
    if (fused) bar = xcd_barrier_post((unsigned*)(kp->ws + WS_CTL) + CW_BAR, MISC + 8);
#define IN(k) (ph_lo <= (k) && (k) < ph_hi)
#define SEAM(k) do { if (IN(k) && IN((k) + 1)) xcd_barrier(bar); } while (0)
#define SEAM_CONV(k, j) do { if (IN(k) && IN((k) + 1)) xcd_barrier_conv(bar, kp, lds, (j) * 7 * G, vcu, wave, lane); } while (0)
#define RUN_GEMM(PH) { GemmCtx<PH> S; S.ws = kp->ws; S.x = kp->x; S.b_up = kp->b_up; S.b_down = kp->b_down; S.fg = kp->ffn_g; S.G = G; S.c = bid; S.T = 0; \
            S.tab = (const LAS int*)(lds + LDS_MOETAB); if (PH >= 7) S.T = moe_table(lds, S.gcount()); \
            gemm_phase<PH>(lds, S); }
    if (IN(0)) p0_prep(kp, lds, gw, NGW, wave, lane, 0);
    SEAM(0);
    if (IN(1)) RUN_GEMM(1)
    SEAM_CONV(1, 0);
    if (IN(2)) {
        for (int u = vcu; u < BATCH * NGRP * 2; u += G) ssm_block(kp, lds, u >> 6, u & 31, (u >> 5) & 1, wave, lane);
        for (int u = vcu; u < BATCH * 32 * 2; u += G) attn_unit(kp, lds, u >> 6, 16 * ((u >> 5) & 1) + ((u & 31) >> 1), u & 1, tid, wave, lane);
        __syncthreads();
        for (int it = 5 * 7 * G + gw; it < I_DN; it += NGW) {
            LAS unsigned* T = (LAS unsigned*)(lds + wave * 8448); const TTile t = p0_item(kp, 1, it); f32x4 v[16]; tt_load8(t, v, lane); tt_store8(t, v, T, lane); }
    }
    SEAM_CONV(2, 1);
    if (IN(4)) RUN_GEMM(4)
    SEAM_CONV(4, 2);
    if (IN(5)) RUN_GEMM(5)
    SEAM_CONV(5, 3);
    if (IN(6)) p6_route(kp, lds, vcu, G, tid, wave, lane);
    SEAM_CONV(6, 4);
    if (IN(7)) RUN_GEMM(7)
    SEAM(7);
    if (IN(8)) RUN_GEMM(8)
    SEAM(8);
    if (IN(9)) p9_combine(kp, gw, NGW, lane);
}

extern "C" void kernel_launch(void* const* d_in, const int* in_sizes, int n_in, void* d_out, int out_size, void* d_ws, size_t ws_size, hipStream_t stream) {
    if (n_in != 24 || out_size != NTOK * D || ws_size < WS_END) { fprintf(stderr, "kernel_launch: unexpected problem (n_in %d out %d ws %zu need %zu)\n", n_in, out_size, ws_size, (size_t)WS_END); return; }
    static int grid = 0;
    if (!grid) {
        int dev = 0, cus = 0;
        if (hipGetDevice(&dev) != hipSuccess || hipDeviceGetAttribute(&cus, hipDeviceAttributeMultiprocessorCount, dev) != hipSuccess) cus = 256;
        if (hipFuncSetAttribute((const void*)mega, hipFuncAttributeMaxDynamicSharedMemorySize, MEGA_LDS) != hipSuccess) fprintf(stderr, "hipFuncSetAttribute failed\n");
        (void)hipGetLastError();
        grid = cus > 0 ? cus : 256;
    }
    P p{};
    const float** pp = (const float**)&p;
    for (int i = 0; i < 24; ++i) pp[i] = (const float*)d_in[i];
    p.out = (float*)d_out; p.ws = (unsigned char*)d_ws;
    (void)hipMemsetAsync((unsigned char*)d_ws + WS_CTL, 0, CTL_BYTES, stream);
#ifndef MK_SPLIT
    mega<<<grid, 512, MEGA_LDS, stream>>>(p, 0, 10);
#else
    for (int ph = 0; ph < 10; ++ph) mega<<<grid, 512, MEGA_LDS, stream>>>(p, ph, ph + 1);
#endif
}
```
